# Optimizing an MI355X kernel written in HIP

```python
import math
import jax, jax.numpy as jnp
from jax import lax
import numpy as np

D_MODEL = 1024
BATCH = 8
SEQ = 2048
DEPTH = 4

N_MEM = 256
EPS = 1e-6
DA_HEADS = 8
DA_HEAD_DIM = D_MODEL // (2 * DA_HEADS)
DA_V_DIM = 2 * DA_HEAD_DIM
DA_QK_WIDTH = 2 * DA_HEADS * DA_HEAD_DIM
DA_V_WIDTH = DA_HEADS * DA_V_DIM
ROPE_THETA = 500000.0
ROT_DIM = DA_HEAD_DIM // 4
Q_BLOCK = 128
CONV_WIDTH = D_MODEL
CONV_K = 3
N_BRANCH = 2
SPLITS = tuple(np.cumsum([DA_QK_WIDTH, DA_QK_WIDTH, DA_V_WIDTH, CONV_WIDTH, CONV_WIDTH, CONV_WIDTH]).tolist())
IN_WIDTH = 2 * DA_QK_WIDTH + DA_V_WIDTH + 3 * CONV_WIDTH + N_BRANCH * D_MODEL
MEM_HEADS = 4
MEM_HEAD_DIM = D_MODEL // MEM_HEADS
N_GROUPS = 4
EXPERTS_PER_GROUP = 8
N_EXPERTS = N_GROUPS * EXPERTS_PER_GROUP
TOP_K = 2
D_EXPERT = 3 * D_MODEL // 4
MOE_BLOCK = 128

kernel_name = 'hybrid_gated_conv_diffattn_hmoe_encoder'


def rms_norm(x, g):
    xf = x.astype(jnp.float32)
    y = xf * lax.rsqrt(jnp.mean(xf * xf, axis=-1, keepdims=True) + EPS)
    return (y * g.astype(jnp.float32)).astype(x.dtype)


def rotary_tables(seq_len):
    inv = jnp.float32(ROPE_THETA) ** (-jnp.arange(0, ROT_DIM, 2, dtype=jnp.float32) / ROT_DIM)
    ang = jnp.arange(seq_len, dtype=jnp.float32)[:, None] * inv[None, :]
    return jnp.cos(ang), jnp.sin(ang)


def partial_rotary(x, cos, sin):
    half = ROT_DIM // 2
    xr = x[..., :ROT_DIM].astype(jnp.float32)
    x1, x2 = xr[..., :half], xr[..., half:]
    c, s = cos[:, None, :], sin[:, None, :]
    rot = jnp.concatenate([x1 * c - x2 * s, x2 * c + x1 * s], axis=-1).astype(x.dtype)
    return jnp.concatenate([rot, x[..., ROT_DIM:]], axis=-1)


def diff_attention(q, k, v, lam):
    _, b, s, h, dh = q.shape
    nb = s // Q_BLOCK
    qb = q.reshape(2, b, nb, Q_BLOCK, h, dh).transpose(2, 0, 1, 3, 4, 5)
    scale = dh ** -0.5

    def one_block(qblk):
        sc = jnp.einsum('cbqhd,cbkhd->cbhqk', qblk, k).astype(jnp.float32) * scale
        p = jax.nn.softmax(sc, axis=-1)
        w = p[0] - lam * p[1]
        return jnp.einsum('bhqk,bkhe->bqhe', w.astype(v.dtype), v)

    o = lax.map(one_block, qb)
    return o.transpose(1, 0, 2, 3, 4).reshape(b, s, h, 2 * dh)


def centred_depthwise_conv(u, w):
    c = u.shape[-1]
    return lax.conv_general_dilated(u, w[:, None, :].astype(u.dtype), window_strides=(1,),
                                    padding=[(CONV_K // 2, CONV_K // 2)],
                                    dimension_numbers=('NWC', 'WIO', 'NWC'), feature_group_count=c)


def hybrid_mixer(h, w_in, lq1, lk1, lq2, lk2, subln, conv_w, w_branch, w_o, lambda_init, cos, sin):
    b, s, _ = h.shape
    proj = h @ w_in
    q, k, v, c_b, c_c, c_x, gates = jnp.split(proj, SPLITS, axis=-1)
    q = jnp.moveaxis(q.reshape(b, s, DA_HEADS, 2, DA_HEAD_DIM), 3, 0)
    k = jnp.moveaxis(k.reshape(b, s, DA_HEADS, 2, DA_HEAD_DIM), 3, 0)
    q = partial_rotary(q, cos, sin)
    k = partial_rotary(k, cos, sin)
    v = v.reshape(b, s, DA_HEADS, DA_V_DIM)
    f32 = jnp.float32
    lam = (jnp.exp(jnp.sum(lq1.astype(f32) * lk1.astype(f32)))
           - jnp.exp(jnp.sum(lq2.astype(f32) * lk2.astype(f32))) + lambda_init)
    o = diff_attention(q, k, v, lam)
    o = rms_norm(o, subln) * (1.0 - lambda_init)
    y_attn = o.reshape(b, s, DA_V_WIDTH)
    y_conv = c_b * centred_depthwise_conv(c_c * c_x, conv_w)
    ys = jnp.stack([y_attn, y_conv], axis=2)
    br = jnp.einsum('bsnc,ncd->bsnd', ys, w_branch)
    g = jax.nn.sigmoid(gates.reshape(b, s, N_BRANCH, D_MODEL))
    return jnp.sum(g * br, axis=2) @ w_o


def memory_cross_attention(h, mem_n, w_cq, w_ckv, w_co):
    b, s, _ = h.shape
    m = mem_n.shape[1]
    q = (h @ w_cq).reshape(b, s, MEM_HEADS, MEM_HEAD_DIM)
    kv = (mem_n @ w_ckv).reshape(b, m, 2, MEM_HEADS, MEM_HEAD_DIM)
    k, v = kv[:, :, 0], kv[:, :, 1]
    sc = jnp.einsum('bshd,bmhd->bhsm', q, k).astype(jnp.float32) * (MEM_HEAD_DIM ** -0.5)
    p = jax.nn.softmax(sc, axis=-1)
    o = jnp.einsum('bhsm,bmhd->bshd', p.astype(v.dtype), v).reshape(b, s, MEM_HEADS * MEM_HEAD_DIM)
    return o @ w_co


def routed_experts(ht, expert_idx, expert_w, w_gate, w_up, w_down):
    t, d = ht.shape
    a = t * TOP_K
    flat_e = expert_idx.reshape(a).astype(jnp.int32)
    order = jnp.argsort(flat_e)
    sorted_e = flat_e[order]
    counts = jnp.bincount(flat_e, length=N_EXPERTS)
    padded = (counts + MOE_BLOCK - 1) // MOE_BLOCK * MOE_BLOCK
    pad_end = jnp.cumsum(padded)
    pad_start = pad_end - padded
    start = jnp.cumsum(counts) - counts
    dest = (pad_start[sorted_e] + jnp.arange(a, dtype=jnp.int32) - start[sorted_e]).astype(jnp.int32)
    n_blocks = -(-a // MOE_BLOCK) + N_EXPERTS
    rows = n_blocks * MOE_BLOCK
    row_tok = jnp.zeros((rows,), jnp.int32).at[dest].set((order // TOP_K).astype(jnp.int32))
    block_expert = jnp.minimum(
        jnp.searchsorted(pad_end, jnp.arange(n_blocks, dtype=jnp.int32) * MOE_BLOCK, side='right'),
        N_EXPERTS - 1)
    xb = ht[row_tok].reshape(n_blocks, MOE_BLOCK, d)

    def expert_block(args):
        xblk, e = args
        return (jax.nn.silu(xblk @ w_gate[e]) * (xblk @ w_up[e])) @ w_down[e]

    yb = lax.map(expert_block, (xb, block_expert)).reshape(rows, d)
    dest_flat = jnp.zeros((a,), jnp.int32).at[order].set(dest)
    y = yb[dest_flat].reshape(t, TOP_K, d)
    return jnp.einsum('tk,tkd->td', expert_w.astype(y.dtype), y)


def hierarchical_moe(h, w_rg, w_re, w_gate, w_up, w_down):
    b, s, d = h.shape
    ht = h.reshape(b * s, d)
    g_prob = jax.nn.softmax((ht @ w_rg).astype(jnp.float32), axis=-1)
    g_w, g_idx = lax.top_k(g_prob, 1)
    e_logits = (ht @ w_re).astype(jnp.float32).reshape(-1, N_GROUPS, EXPERTS_PER_GROUP)
    e_logits = jnp.take_along_axis(e_logits, g_idx[:, :, None], axis=1)[:, 0]
    e_prob = jax.nn.softmax(e_logits, axis=-1)
    e_w, e_idx = lax.top_k(e_prob, TOP_K)
    e_w = e_w / jnp.sum(e_w, axis=-1, keepdims=True)
    weights = g_w * e_w
    expert_idx = g_idx * EXPERTS_PER_GROUP + e_idx
    return routed_experts(ht, expert_idx, weights, w_gate, w_up, w_down).reshape(b, s, d)


def setup_inputs(seed: int = 0) -> dict:
    key = jax.random.key(seed)
    ks = jax.random.split(key, 24)
    f32 = jnp.float32
    res = (2.0 * DEPTH) ** -0.5

    def nrm(k, shape, scale):
        return jax.random.normal(k, shape, f32) * scale

    def gain(k, shape):
        return 1.0 + 0.02 * jax.random.normal(k, shape, f32)

    return {
        'x': nrm(ks[0], (BATCH, SEQ, D_MODEL), 1.0),
        'mem': nrm(ks[1], (BATCH, N_MEM, D_MODEL), 1.0),
        'norm_mix': gain(ks[2], (DEPTH, D_MODEL)),
        'w_in': nrm(ks[3], (DEPTH, D_MODEL, IN_WIDTH), D_MODEL ** -0.5),
        'lambda_q1': nrm(ks[4], (DEPTH, DA_HEAD_DIM), 0.1),
        'lambda_k1': nrm(ks[5], (DEPTH, DA_HEAD_DIM), 0.1),
        'lambda_q2': nrm(ks[6], (DEPTH, DA_HEAD_DIM), 0.1),
        'lambda_k2': nrm(ks[7], (DEPTH, DA_HEAD_DIM), 0.1),
        'subln': gain(ks[8], (DEPTH, DA_V_DIM)),
        'conv_w': nrm(ks[9], (DEPTH, CONV_K, CONV_WIDTH), CONV_K ** -0.5),
        'w_branch': nrm(ks[10], (DEPTH, N_BRANCH, D_MODEL, D_MODEL), D_MODEL ** -0.5),
        'w_o': nrm(ks[11], (DEPTH, D_MODEL, D_MODEL), res * D_MODEL ** -0.5),
        'norm_cross': gain(ks[12], (DEPTH, D_MODEL)),
        'norm_mem': gain(ks[13], (D_MODEL,)),
        'w_cq': nrm(ks[14], (DEPTH, D_MODEL, MEM_HEADS * MEM_HEAD_DIM), D_MODEL ** -0.5),
        'w_ckv': nrm(ks[15], (DEPTH, D_MODEL, 2 * MEM_HEADS * MEM_HEAD_DIM), D_MODEL ** -0.5),
        'w_co': nrm(ks[16], (DEPTH, MEM_HEADS * MEM_HEAD_DIM, D_MODEL), res * D_MODEL ** -0.5),
        'norm_ffn': gain(ks[17], (DEPTH, D_MODEL)),
        'w_router_group': nrm(ks[18], (DEPTH, D_MODEL, N_GROUPS), D_MODEL ** -0.5),
        'w_router_expert': nrm(ks[19], (DEPTH, D_MODEL, N_EXPERTS), D_MODEL ** -0.5),
        'w_exp_gate': nrm(ks[20], (DEPTH, N_EXPERTS, D_MODEL, D_EXPERT), D_MODEL ** -0.5),
        'w_exp_up': nrm(ks[21], (DEPTH, N_EXPERTS, D_MODEL, D_EXPERT), D_MODEL ** -0.5),
        'w_exp_down': nrm(ks[22], (DEPTH, N_EXPERTS, D_EXPERT, D_MODEL), res * D_EXPERT ** -0.5),
        'norm_final': gain(ks[23], (D_MODEL,)),
    }


def reference(x, mem, norm_mix, w_in, lambda_q1, lambda_k1, lambda_q2, lambda_k2, subln, conv_w,
              w_branch, w_o, norm_cross, norm_mem, w_cq, w_ckv, w_co, norm_ffn, w_router_group,
              w_router_expert, w_exp_gate, w_exp_up, w_exp_down, norm_final):
    cos, sin = rotary_tables(x.shape[1])
    mem_n = rms_norm(mem, norm_mem)
    for l in range(DEPTH):
        lambda_init = 0.8 - 0.6 * math.exp(-0.3 * l)
        x = x + hybrid_mixer(rms_norm(x, norm_mix[l]), w_in[l], lambda_q1[l], lambda_k1[l],
                             lambda_q2[l], lambda_k2[l], subln[l], conv_w[l], w_branch[l], w_o[l],
                             lambda_init, cos, sin)
        x = x + memory_cross_attention(rms_norm(x, norm_cross[l]), mem_n, w_cq[l], w_ckv[l], w_co[l])
        x = x + hierarchical_moe(rms_norm(x, norm_ffn[l]), w_router_group[l], w_router_expert[l],
                                 w_exp_gate[l], w_exp_up[l], w_exp_down[l])
    return rms_norm(x, norm_final)
```

```cpp
#include <hip/hip_runtime.h>
#include <cstdio>
#include <cstdint>

#ifndef MK_SPLIT
#define MK_SPLIT 1
#endif

#define LAS __attribute__((address_space(3)))
#define GAS __attribute__((address_space(1)))
typedef unsigned short bf16_t;
typedef short bf16x8 __attribute__((ext_vector_type(8)));
typedef short s16x4 __attribute__((ext_vector_type(4)));
typedef float f32x2 __attribute__((ext_vector_type(2)));
typedef float f32x4 __attribute__((ext_vector_type(4)));
typedef float f32x16 __attribute__((ext_vector_type(16)));
typedef unsigned u32x2 __attribute__((ext_vector_type(2)));
typedef unsigned u32x4 __attribute__((ext_vector_type(4)));

constexpr int T = 16384, DM = 1024, NB = 8, SEQ = 2048, NL = 4, NMEM = 256, MT = NB * NMEM;
constexpr int INW = 8192, NE = 32, DE = 768, NHD = 8;
constexpr float EPS = 1e-6f;
constexpr float QSCALE = 0.18033688011112042f;
constexpr float CQSCALE = 0.09016844005556021f;
constexpr int MAXROWS = 40960;
constexpr int NPH_L = 11, NPHASE = 1 + NL * NPH_L;

constexpr size_t MiB = 1u << 20;
constexpr size_t WS_CTL = 0, CTL_ZERO_BYTES = 1 * MiB;
constexpr size_t WS_ROPE = 1 * MiB;
constexpr size_t WS_PART = 2 * MiB;
constexpr size_t WS_TOK = 3 * MiB;
constexpr size_t WS_ELIST = 4 * MiB;
constexpr size_t WS_MEMN = 6 * MiB;
constexpr size_t WS_KVC = 10 * MiB;
constexpr size_t WS_XB = 42 * MiB;
constexpr size_t WS_Q = 74 * MiB, WS_K = 106 * MiB, WS_V = 138 * MiB, WS_U = 170 * MiB, WS_CB = 202 * MiB;
constexpr size_t WS_G = 234 * MiB;
constexpr size_t WS_YA = 298 * MiB, WS_YC = 330 * MiB, WS_M = 362 * MiB;
constexpr size_t WS_QC = WS_Q, WS_OC = WS_K;
constexpr size_t WS_ACT = 394 * MiB;
constexpr size_t WS_Y = 454 * MiB;
constexpr size_t WS_W = 534 * MiB;
constexpr size_t WL_IN = 0, WL_BR = 16 * MiB, WL_O = 20 * MiB, WL_CQ = 22 * MiB, WL_CKV = 24 * MiB, WL_CO = 28 * MiB, WL_GU = 30 * MiB, WL_DN = 126 * MiB, WL_SZ = 174 * MiB;
constexpr size_t WS_END = WS_W + NL * WL_SZ;
constexpr int CW_BAR = 4096;
constexpr int CW_ECNT = 16384;

constexpr int RING_BYTES = 131072;
constexpr int LDSCTL_OFF = 145408;
constexpr int LDS_BYTES = 147456;
constexpr int LC_MISC = LDSCTL_OFF;
constexpr int LC_BST = LDSCTL_OFF + 256, LC_CNT = LDSCTL_OFF + 512, LC_BEXP = LDSCTL_OFF + 1024;

__device__ __forceinline__ unsigned cvt_pk_bf16(float lo, float hi) { unsigned r; asm volatile("v_cvt_pk_bf16_f32 %0, %1, %2" : "=v"(r) : "v"(lo), "v"(hi)); return r; }
__device__ __forceinline__ float bf_lo(unsigned w) { return __uint_as_float(w << 16); }
__device__ __forceinline__ float bf_hi(unsigned w) { return __uint_as_float(w & 0xffff0000u); }
template <int M> __device__ __forceinline__ float swz_xor(float v) { return __int_as_float(__builtin_amdgcn_ds_swizzle(__float_as_int(v), (M << 10) | 0x1f)); }
__device__ __forceinline__ float half_sum(float v) { auto rr = __builtin_amdgcn_permlane32_swap(__float_as_uint(v), __float_as_uint(v), false, false); return __uint_as_float(rr[0]) + __uint_as_float(rr[1]); }
__device__ __forceinline__ float sum32(float v) { v += swz_xor<1>(v); v += swz_xor<2>(v); v += swz_xor<4>(v); v += swz_xor<8>(v); v += swz_xor<16>(v); return v; }
__device__ __forceinline__ float wave_sum(float v) { return half_sum(sum32(v)); }
#define LDS_WAIT() asm volatile("s_waitcnt lgkmcnt(0)" ::: "memory")
#define VM_WAIT() asm volatile("s_waitcnt vmcnt(0)" ::: "memory")
__device__ __forceinline__ float lambda_init(int l) { return l == 0 ? 0.2f : l == 1 ? 0.35550906759096934f : l == 2 ? 0.4707130183435842f : 0.5560582041556406f; }
__device__ __forceinline__ float row_rscale(const float* part, int row) {
    const f32x4* p = (const f32x4*)(part + (size_t)row * 16);
    const f32x4 a = p[0], b = p[1], c = p[2], d = p[3];
    const float s = ((a[0] + a[1]) + (a[2] + a[3])) + ((b[0] + b[1]) + (b[2] + b[3])) + (((c[0] + c[1]) + (c[2] + c[3])) + ((d[0] + d[1]) + (d[2] + d[3])));
    return 1.0f / sqrtf(s * (1.0f / DM) + EPS);
}

namespace pg8 {
constexpr int BM = 256, BK = 64, HALF = 128, HTB = HALF * BK * 2, STAGE_BYTES = 8 * HTB;
__host__ __device__ __forceinline__ int lds_byte(int r, int c) { const int st = (r >> 4) * 2 + (c >> 5), rr = r & 15, cc = c & 31, ob = rr * 64 + cc * 2; return st * 1024 + (ob ^ (((ob >> 9) & 1) << 5)); }
__host__ __device__ __forceinline__ void stage_rc(int b, int& R, int& C) { const int st = b / 1024, sb = b % 1024, swz = sb ^ (((sb >> 9) & 1) << 5); R = (st >> 1) * 16 + swz / 64; C = (st & 1) * 32 + (swz % 64) / 2; }
__host__ __device__ __forceinline__ int perm32(int rho) { const int n = rho >> 4, i = rho & 15; return 8 * (i >> 2) + 4 * n + (i & 3); }

struct Unit { const char* A; const char* B; const int* gidx; int pm, pn, aux, nvalid; };

template <class Epi, class Sched, bool GATHER, bool ALIGN_EPI>
__device__ __forceinline__ void gemm_phase(LAS unsigned char* lds, const int K, const int lda, const Sched& S, const Epi& E) {
    int tid_ = threadIdx.x; asm volatile("" : "+v"(tid_));
    const int tid = tid_, wid = __builtin_amdgcn_readfirstlane(tid >> 6), lane = tid & 63, wr = wid >> 2, wc = wid & 3, fr = lane & 15, fq = lane >> 4;
    const int nt = K / BK;
    constexpr int NH = GATHER ? 2 : 1;
    unsigned voffB[2], voffA[NH][2], voffAn[NH][2];
#pragma unroll
    for (int i = 0; i < 2; ++i) { int R, C; stage_rc(tid * 16 + i * 8192, R, C); const int Rb = Epi::PERM ? ((R & ~31) + perm32(R & 31)) : R;
        voffB[i] = (unsigned)(Rb * K + C) * 2u; if constexpr (!GATHER) voffA[0][i] = (unsigned)(R * lda + C) * 2u; }
    const size_t kstep = (size_t)(BK * 2);
    const size_t hstepB = (size_t)HALF * K * 2, hstepA = GATHER ? 0 : (size_t)HALF * lda * 2;
    const unsigned ldsw = (unsigned)wid * 1024u;
    const int aoff = lds_byte(wr * 64 + fr, fq * 8), boff = lds_byte(wc * 32 + fr, fq * 8);
#define PG8_SA(b, h) (((b) * 2 + (h)) * HTB)
#define PG8_SB(b, h) ((4 + (b) * 2 + (h)) * HTB)
#define PG8_STAGE(bufoff, gbase, voff) do { _Pragma("unroll") for (int _i = 0; _i < 2; ++_i) \
        __builtin_amdgcn_global_load_lds((const unsigned*)((const char*)(gbase) + (voff)[_i]), (LAS unsigned*)(lds + (bufoff) + ldsw + _i * 8192), 16, 0, 0); } while (0)
#define PG8_STAGE_A(bufoff, gbase, h, nx) do { if constexpr (GATHER) { unsigned _v[2]; _v[0] = (nx) ? voffAn[h][0] : voffA[h][0]; _v[1] = (nx) ? voffAn[h][1] : voffA[h][1]; PG8_STAGE(bufoff, gbase, _v); } \
        else PG8_STAGE(bufoff, (gbase) + (h) * hstepA, voffA[0]); } while (0)
#define PG8_LDA(dst, b, h) do { _Pragma("unroll") for (int m = 0; m < 4; ++m) _Pragma("unroll") for (int k = 0; k < 2; ++k) dst[m][k] = *(const LAS bf16x8*)(lds + PG8_SA(b, h) + aoff + m * 2048 + k * 1024); } while (0)
#define PG8_LDB(dst, b, h) do { _Pragma("unroll") for (int n = 0; n < 2; ++n) _Pragma("unroll") for (int k = 0; k < 2; ++k) dst[n][k] = *(const LAS bf16x8*)(lds + PG8_SB(b, h) + boff + n * 2048 + k * 1024); } while (0)
#define PG8_MMA(ai, bj, At, Bt) do { __builtin_amdgcn_s_setprio(1); _Pragma("unroll") for (int m = 0; m < 4; ++m) _Pragma("unroll") for (int n = 0; n < 2; ++n) _Pragma("unroll") for (int k = 0; k < 2; ++k) \
        acc[ai][bj][m][n] = __builtin_amdgcn_mfma_f32_16x16x32_bf16(Bt[n][k], At[m][k], acc[ai][bj][m][n], 0, 0, 0); __builtin_amdgcn_s_setprio(0); } while (0)
#define PG8_WAIT_V(n) asm volatile("s_waitcnt vmcnt(" #n ")" ::: "memory")
#define PG8_WAIT_L(n) asm volatile("s_waitcnt lgkmcnt(" #n ")" ::: "memory")
#define PG8_BAR __builtin_amdgcn_s_barrier()
#define PG8_SCHED __builtin_amdgcn_sched_barrier(0)
#define PG8_VOFFA(dst, u) do { if constexpr (GATHER) { _Pragma("unroll") for (int _h = 0; _h < 2; ++_h) _Pragma("unroll") for (int _i = 0; _i < 2; ++_i) { \
        int _R, _C; stage_rc(tid * 16 + _i * 8192, _R, _C); const int _r = _h * HALF + _R; const int _t = (_r < (u).nvalid) ? (u).gidx[_r] : 0; dst[_h][_i] = (unsigned)(_t * lda + _C) * 2u; } } } while (0)
    Unit cur, nxt; int ui = 0;
    if (!S.next(0, cur)) return;
    PG8_VOFFA(voffA, cur);
    f32x4 acc[2][2][4][2];
#pragma unroll
    for (int a = 0; a < 2; ++a)
#pragma unroll
        for (int b = 0; b < 2; ++b)
#pragma unroll
            for (int m = 0; m < 4; ++m)
#pragma unroll
                for (int n = 0; n < 2; ++n) acc[a][b][m][n] = (f32x4){0.f, 0.f, 0.f, 0.f};
    bf16x8 At[4][2], B0[2][2], B1[2][2];
    const char* cA = cur.A; const char* cB = cur.B;
    PG8_STAGE(PG8_SB(0, 0), cB, voffB); PG8_STAGE(PG8_SB(0, 1), cB + hstepB, voffB); PG8_STAGE_A(PG8_SA(0, 0), cA, 0, false); PG8_STAGE_A(PG8_SA(0, 1), cA, 1, false);
    if (wr == 1) PG8_BAR;
    PG8_WAIT_V(2); PG8_BAR;
    PG8_STAGE(PG8_SB(1, 0), cB + kstep, voffB); PG8_STAGE_A(PG8_SA(1, 0), cA + kstep, 0, false); PG8_STAGE(PG8_SB(1, 1), cB + hstepB + kstep, voffB);
    PG8_WAIT_V(6); PG8_BAR;
    for (;;) {
        const bool has_next = S.next(ui + 1, nxt);
        if constexpr (GATHER) {
            if (has_next) { PG8_VOFFA(voffAn, nxt); }
            else {
#pragma unroll
                for (int h = 0; h < NH; ++h)
#pragma unroll
                    for (int i = 0; i < 2; ++i) voffAn[h][i] = voffA[h][i];
            }
        }
        const char* nA = has_next ? nxt.A : cA; const char* nB = has_next ? nxt.B : cB;
        for (int t = 0; t < nt; t += 2) {
            const bool last = (t == nt - 2);
            const char* a1 = cA + (size_t)(t + 1) * kstep;
            const char* a2 = last ? nA : cA + (size_t)(t + 2) * kstep; const char* b2 = last ? nB : cB + (size_t)(t + 2) * kstep;
            const char* a3 = a2 + kstep; const char* b3 = b2 + kstep;
            PG8_LDB(B0, 0, 0); PG8_LDB(B1, 0, 1); PG8_SCHED; PG8_LDA(At, 0, 0); PG8_STAGE_A(PG8_SA(1, 1), a1, 1, false);
            PG8_WAIT_V(8); PG8_WAIT_L(0); PG8_BAR; PG8_MMA(0, 0, At, B0); PG8_MMA(0, 1, At, B1); PG8_BAR; PG8_SCHED;
            PG8_LDA(At, 0, 1); PG8_STAGE(PG8_SB(0, 0), b2, voffB); PG8_STAGE(PG8_SB(0, 1), b2 + hstepB, voffB); PG8_STAGE_A(PG8_SA(0, 0), a2, 0, last);
            PG8_WAIT_V(8); PG8_WAIT_L(0); PG8_BAR; PG8_MMA(1, 0, At, B0); PG8_MMA(1, 1, At, B1); PG8_BAR; PG8_SCHED;
            PG8_LDB(B0, 1, 0); PG8_LDB(B1, 1, 1); PG8_SCHED; PG8_LDA(At, 1, 0); PG8_STAGE_A(PG8_SA(0, 1), a2, 1, last);
            PG8_WAIT_V(8); PG8_WAIT_L(0); PG8_BAR; PG8_MMA(0, 0, At, B0); PG8_MMA(0, 1, At, B1); PG8_BAR; PG8_SCHED;
            PG8_LDA(At, 1, 1); PG8_STAGE(PG8_SB(1, 0), b3, voffB); PG8_STAGE(PG8_SB(1, 1), b3 + hstepB, voffB); PG8_STAGE_A(PG8_SA(1, 0), a3, 0, last);
            PG8_WAIT_V(8); PG8_WAIT_L(0); PG8_BAR; PG8_MMA(1, 0, At, B0); PG8_MMA(1, 1, At, B1); PG8_BAR; PG8_SCHED;
        }
        if constexpr (ALIGN_EPI) { if (wr == 0) PG8_BAR; }
        const bool keep = E(acc, cur, wr, wc, fr, fq);
        if (!has_next) break;
        if (!keep) {
#pragma unroll
            for (int a = 0; a < 2; ++a)
#pragma unroll
                for (int b = 0; b < 2; ++b)
#pragma unroll
                    for (int m = 0; m < 4; ++m)
#pragma unroll
                        for (int n = 0; n < 2; ++n) acc[a][b][m][n] = (f32x4){0.f, 0.f, 0.f, 0.f};
        }
        cur = nxt; cA = nA; cB = nB; ++ui;
        if constexpr (GATHER) {
#pragma unroll
            for (int h = 0; h < NH; ++h)
#pragma unroll
                for (int i = 0; i < 2; ++i) voffA[h][i] = voffAn[h][i];
        }
        if constexpr (ALIGN_EPI) { if (wr == 1) PG8_BAR; }
    }
    PG8_WAIT_V(0);
    if constexpr (!ALIGN_EPI) { if (wr == 0) PG8_BAR; }
    PG8_BAR;
#undef PG8_SA
#undef PG8_SB
#undef PG8_STAGE
#undef PG8_STAGE_A
#undef PG8_LDA
#undef PG8_LDB
#undef PG8_MMA
#undef PG8_WAIT_V
#undef PG8_WAIT_L
#undef PG8_BAR
#undef PG8_SCHED
#undef PG8_VOFFA
}
}

struct DenseSched {
    const char* A; const char* B; size_t astep, bstep; int nM, nN, nwg, G, c;
    __device__ __forceinline__ void init(const void* A_, const void* B_, int M, int N, int K, int lda, int G_, int c_) {
        A = (const char*)A_; B = (const char*)B_; astep = (size_t)256 * lda * 2; bstep = (size_t)256 * K * 2; nM = M / 256; nN = N / 256; nwg = nM * nN; G = G_; c = c_; }
    __device__ __forceinline__ bool next(int i, pg8::Unit& u) const {
        const long L = (long)i * G + c; if (L >= nwg) return false;
        int wgid = (int)L; { const int q = nwg / 8, r = nwg % 8, xcd = wgid % 8, off = wgid / 8; wgid = (xcd < r ? xcd * (q + 1) : r * (q + 1) + (xcd - r) * q) + off; }
        const int nig = 8 * nN, gid = wgid / nig, fm = gid * 8, gsz = (nM - fm) < 8 ? (nM - fm) : 8;
        u.pm = fm + ((wgid % nig) % gsz); u.pn = (wgid % nig) / gsz; u.aux = 0; u.gidx = nullptr; u.nvalid = 256;
        u.A = A + (size_t)u.pm * astep; u.B = B + (size_t)u.pn * bstep; return true;
    }
};
struct BrSched {
    DenseSched d; const char* A1; const char* B1;
    __device__ __forceinline__ bool next(int i, pg8::Unit& u) const {
        if (!d.next(i >> 1, u)) return false;
        if (i & 1) { u.A = A1 + (size_t)u.pm * d.astep; u.B = B1 + (size_t)u.pn * d.bstep; u.aux = 1; }
        return true;
    }
};
struct KvcSched {
    const char* A; const char* B; int G, c;
    __device__ __forceinline__ bool next(int i, pg8::Unit& u) const {
        const int L = i * G + c; if (L >= 256) return false;
        const int l = L >> 6, r = L & 63; u.pm = r & 7; u.pn = r >> 3; u.aux = l; u.gidx = nullptr; u.nvalid = 256;
        u.A = A + (size_t)u.pm * (256 * DM * 2); u.B = B + (size_t)l * WL_SZ + (size_t)u.pn * (256 * DM * 2); return true;
    }
};
struct MoeSched {
    const LAS int* bst; const LAS int* cnt; const LAS int* bexp; const char* A; const char* B; const int* elist; size_t estride, tstride; int ntile, G, c; bool gather;
    __device__ __forceinline__ bool next(int i, pg8::Unit& u) const {
        const int nblk = bst[32]; const int L = i * G + c; if (L >= nblk * ntile) return false;
        const int blk = L / ntile, j = L - blk * ntile;
        const int e = __builtin_amdgcn_readfirstlane(bexp[blk]);
        const int rb = blk - __builtin_amdgcn_readfirstlane(bst[e]); const int ce = __builtin_amdgcn_readfirstlane(cnt[e]);
        u.pm = blk; u.pn = j; u.aux = e; u.nvalid = (ce - rb * 256) < 256 ? (ce - rb * 256) : 256;
        u.gidx = elist + (size_t)e * T + rb * 256;
        u.A = gather ? A : A + (size_t)blk * 256 * DE * 2;
        u.B = B + (size_t)e * estride + (size_t)j * tstride; return true;
    }
};

__device__ __forceinline__ void st8(bf16_t* p, f32x4 v0, f32x4 v1) {
    u32x4 w; w.x = cvt_pk_bf16(v0[0], v0[1]); w.y = cvt_pk_bf16(v0[2], v0[3]); w.z = cvt_pk_bf16(v1[0], v1[1]); w.w = cvt_pk_bf16(v1[2], v1[3]); *(u32x4*)p = w; }
__device__ __forceinline__ float sigmoidf_(float x) { return 1.0f / (1.0f + __expf(-x)); }

struct EpiIn {
    static constexpr bool PERM = true;
    const float* part; const float* cosT; const float* sinT; bf16_t *Q, *Kb, *V, *U, *CB, *G;
    __device__ __forceinline__ bool operator()(f32x4 (&acc)[2][2][4][2], const pg8::Unit& u, int wr, int wc, int fr, int fq) const {
        const int pn = u.pn, row0 = u.pm * 256 + wr * 64 + fr;
#define RS_AT(ai, m) row_rscale(part, row0 + (ai) * 128 + (m) * 16)
#define EFENCE() asm volatile("" ::: "memory")
        if (pn < 8) {
            bf16_t* dst = pn < 4 ? Q : Kb; const float sc = pn < 4 ? QSCALE : 1.0f; const int colb = (pn & 3) * 256 + wc * 32 + 8 * fq;
            const bool rot = ((wc & 1) == 0) && (fq < 2);
#pragma unroll
            for (int ai = 0; ai < 2; ++ai)
#pragma unroll
                for (int m = 0; m < 4; ++m) { const int row = row0 + ai * 128 + m * 16; f32x4 c4 = {1.f, 1.f, 1.f, 1.f}, s4 = {0.f, 0.f, 0.f, 0.f}; const float rsv = RS_AT(ai, m);
                    if (rot) { const int t = row & (SEQ - 1); c4 = *(const f32x4*)(cosT + t * 8 + 4 * fq); s4 = *(const f32x4*)(sinT + t * 8 + 4 * fq); }
#pragma unroll
                    for (int bj = 0; bj < 2; ++bj) { f32x4 x1 = acc[ai][bj][m][0] * rsv, x2 = acc[ai][bj][m][1] * rsv;
                        const f32x4 y1 = x1 * c4 - x2 * s4, y2 = x2 * c4 + x1 * s4;
                        if (rot) { x1 = y1; x2 = y2; }
                        st8(dst + (size_t)row * DM + colb + bj * 128, x1 * sc, x2 * sc); } EFENCE(); }
        } else if (pn < 16) {
            bf16_t* dst = pn < 12 ? V : CB; const int colb = (pn & 3) * 256 + wc * 32 + 8 * fq;
#pragma unroll
            for (int ai = 0; ai < 2; ++ai)
#pragma unroll
                for (int m = 0; m < 4; ++m) { const int row = row0 + ai * 128 + m * 16; const float rsv = RS_AT(ai, m);
#pragma unroll
                    for (int bj = 0; bj < 2; ++bj) st8(dst + (size_t)row * DM + colb + bj * 128, acc[ai][bj][m][0] * rsv, acc[ai][bj][m][1] * rsv); EFENCE(); }
        } else if (pn < 24) {
            const int colb = (pn - 16) * 128 + wc * 32 + 8 * fq;
#pragma unroll
            for (int ai = 0; ai < 2; ++ai)
#pragma unroll
                for (int m = 0; m < 4; ++m) { const int row = row0 + ai * 128 + m * 16; const float rsv = RS_AT(ai, m); const float r2 = rsv * rsv;
                    st8(U + (size_t)row * DM + colb, acc[ai][0][m][0] * acc[ai][1][m][0] * r2, acc[ai][0][m][1] * acc[ai][1][m][1] * r2); EFENCE(); }
        } else {
            const int colb = (pn - 24) * 256 + wc * 32 + 8 * fq;
#pragma unroll
            for (int ai = 0; ai < 2; ++ai)
#pragma unroll
                for (int m = 0; m < 4; ++m) { const int row = row0 + ai * 128 + m * 16; const float rsv = RS_AT(ai, m);
#pragma unroll
                    for (int bj = 0; bj < 2; ++bj) { f32x4 a = acc[ai][bj][m][0] * rsv, b = acc[ai][bj][m][1] * rsv;
#pragma unroll
                        for (int j = 0; j < 4; ++j) { a[j] = sigmoidf_(a[j]); b[j] = sigmoidf_(b[j]); }
                        st8(G + (size_t)row * 2048 + colb + bj * 128, a, b); } EFENCE(); }
        }
#undef RS_AT
        return false;
    }
};
struct EpiPlain {
    static constexpr bool PERM = true;
    bf16_t* O; int ldc; const float* part; float scale; size_t aux_stride;
    __device__ __forceinline__ bool operator()(f32x4 (&acc)[2][2][4][2], const pg8::Unit& u, int wr, int wc, int fr, int fq) const {
        const int row0 = u.pm * 256 + wr * 64 + fr, colb = u.pn * 256 + wc * 32 + 8 * fq; bf16_t* base = O + (size_t)u.aux * aux_stride;
#pragma unroll
        for (int ai = 0; ai < 2; ++ai)
#pragma unroll
            for (int m = 0; m < 4; ++m) { const int row = row0 + ai * 128 + m * 16; const float s = part ? row_rscale(part, row) * scale : scale;
#pragma unroll
                for (int bj = 0; bj < 2; ++bj) st8(base + (size_t)row * ldc + colb + bj * 128, acc[ai][bj][m][0] * s, acc[ai][bj][m][1] * s); }
        return false;
    }
};
struct EpiRes {
    static constexpr bool PERM = false;
    const float* xin; float* xout; bf16_t* xb; float* part;
    __device__ __forceinline__ bool operator()(f32x4 (&acc)[2][2][4][2], const pg8::Unit& u, int wr, int wc, int fr, int fq) const {
        const int row0 = u.pm * 256 + wr * 64 + fr, col0 = u.pn * 256 + wc * 32 + 4 * fq;
#pragma unroll
        for (int ai = 0; ai < 2; ++ai)
#pragma unroll
            for (int m = 0; m < 4; ++m) { const int row = row0 + ai * 128 + m * 16; float ss = 0.f;
#pragma unroll
                for (int bj = 0; bj < 2; ++bj)
#pragma unroll
                    for (int n = 0; n < 2; ++n) { const size_t off = (size_t)row * DM + col0 + bj * 128 + n * 16;
                        const f32x4 xv = *(const f32x4*)(xin + off) + acc[ai][bj][m][n]; *(f32x4*)(xout + off) = xv;
                        ss += (xv[0] * xv[0] + xv[1] * xv[1]) + (xv[2] * xv[2] + xv[3] * xv[3]);
                        u32x2 w; w.x = cvt_pk_bf16(xv[0], xv[1]); w.y = cvt_pk_bf16(xv[2], xv[3]); *(u32x2*)(xb + off) = w; }
                ss += swz_xor<16>(ss); ss = half_sum(ss);
                if (fq == 0) part[(size_t)row * 16 + u.pn * 4 + wc] = ss; }
        return false;
    }
};
struct EpiBr {
    static constexpr bool PERM = true;
    const bf16_t* G; bf16_t* Mo;
    __device__ __forceinline__ bool operator()(f32x4 (&acc)[2][2][4][2], const pg8::Unit& u, int wr, int wc, int fr, int fq) const {
        const int row0 = u.pm * 256 + wr * 64 + fr, colb = u.pn * 256 + wc * 32 + 8 * fq; const bool first = (u.aux == 0);
#pragma unroll
        for (int ai = 0; ai < 2; ++ai)
#pragma unroll
            for (int m = 0; m < 4; ++m) { const int row = row0 + ai * 128 + m * 16;
#pragma unroll
                for (int bj = 0; bj < 2; ++bj) { const u32x4 g0 = *(const u32x4*)(G + (size_t)row * 2048 + colb + bj * 128), g1 = *(const u32x4*)(G + (size_t)row * 2048 + 1024 + colb + bj * 128);
                    f32x4 a0 = {bf_lo(g0.x), bf_hi(g0.x), bf_lo(g0.y), bf_hi(g0.y)}, a1 = {bf_lo(g0.z), bf_hi(g0.z), bf_lo(g0.w), bf_hi(g0.w)};
                    f32x4 b0 = {bf_lo(g1.x), bf_hi(g1.x), bf_lo(g1.y), bf_hi(g1.y)}, b1 = {bf_lo(g1.z), bf_hi(g1.z), bf_lo(g1.w), bf_hi(g1.w)};
                    if (first) {
#pragma unroll
                        for (int j = 0; j < 4; ++j) { acc[ai][bj][m][0][j] *= a0[j] / b0[j]; acc[ai][bj][m][1][j] *= a1[j] / b1[j]; }
                    } else st8(Mo + (size_t)row * DM + colb + bj * 128, acc[ai][bj][m][0] * b0, acc[ai][bj][m][1] * b1); } }
        return first;
    }
};
struct EpiGU {
    static constexpr bool PERM = true;
    const float* part; bf16_t* ACT;
    __device__ __forceinline__ bool operator()(f32x4 (&acc)[2][2][4][2], const pg8::Unit& u, int wr, int wc, int fr, int fq) const {
        const int colb = u.pn * 128 + wc * 32 + 8 * fq;
#pragma unroll
        for (int ai = 0; ai < 2; ++ai)
#pragma unroll
            for (int m = 0; m < 4; ++m) { const int rl = ai * 128 + wr * 64 + m * 16 + fr; const int tok = (rl < u.nvalid) ? u.gidx[rl] : 0; const float s = row_rscale(part, tok);
                f32x4 o[2];
#pragma unroll
                for (int n = 0; n < 2; ++n) { const f32x4 g = acc[ai][0][m][n] * s, up = acc[ai][1][m][n] * s;
#pragma unroll
                    for (int j = 0; j < 4; ++j) o[n][j] = g[j] * sigmoidf_(g[j]) * up[j]; }
                st8(ACT + (size_t)(u.pm * 256 + rl) * DE + colb, o[0], o[1]); }
        return false;
    }
};

namespace att {
#define SBAR() __builtin_amdgcn_sched_barrier(0)
constexpr float THR2 = 11.541560327111707f;
__device__ __forceinline__ int crow(int r, int hi) { return (r & 3) + 8 * (r >> 2) + 4 * hi; }
template <int DQK> __device__ __forceinline__ int kswz(int row, int colB) {
    if constexpr (DQK == 64) return row * 128 + (colB ^ (((row >> 1) & 7) << 4));
    else return row * 512 + (colB ^ ((row & 15) << 4));
}
__device__ __forceinline__ void partialSM(f32x16& p0, f32x16& p1, float& m_reg, float& mn, float& alpha) {
    float pmax = p0[0];
#pragma unroll
    for (int r = 1; r < 16; ++r) pmax = fmaxf(pmax, p0[r]);
#pragma unroll
    for (int r = 0; r < 16; ++r) pmax = fmaxf(pmax, p1[r]);
    { auto rr = __builtin_amdgcn_permlane32_swap(__float_as_uint(pmax), __float_as_uint(pmax), false, false);
      pmax = fmaxf(__uint_as_float(rr[0]), __uint_as_float(rr[1])); }
    if (__builtin_expect(__all(pmax - m_reg <= THR2), 1)) { mn = m_reg; alpha = 1.f; }
    else { mn = fmaxf(m_reg, pmax); alpha = __builtin_amdgcn_exp2f(m_reg - mn); m_reg = mn; }
#pragma unroll
    for (int r = 0; r < 16; ++r) p0[r] = p0[r] - mn;
#pragma unroll
    for (int r = 0; r < 16; ++r) p1[r] = p1[r] - mn;
#pragma unroll
    for (int r = 0; r < 16; ++r) p0[r] = __builtin_amdgcn_exp2f(p0[r]);
}
__device__ __forceinline__ void finishSM(f32x16& p0, f32x16& p1, float alpha, float& l_reg, bf16x8& pa0, bf16x8& pa1, bf16x8& pa2, bf16x8& pa3) {
#pragma unroll
    for (int r = 0; r < 16; ++r) p1[r] = __builtin_amdgcn_exp2f(p1[r]);
    float ps = 0;
#pragma unroll
    for (int r = 0; r < 16; ++r) ps += p0[r];
#pragma unroll
    for (int r = 0; r < 16; ++r) ps += p1[r];
    { auto rr = __builtin_amdgcn_permlane32_swap(__float_as_uint(ps), __float_as_uint(ps), false, false);
      ps = __uint_as_float(rr[0]) + __uint_as_float(rr[1]); }
    l_reg = l_reg * alpha + ps;
#define PK4(P, BASE, OUT) do { unsigned a0 = cvt_pk_bf16(P[BASE + 0], P[BASE + 1]), a1 = cvt_pk_bf16(P[BASE + 2], P[BASE + 3]);   \
    unsigned b0 = cvt_pk_bf16(P[BASE + 4], P[BASE + 5]), b1 = cvt_pk_bf16(P[BASE + 6], P[BASE + 7]);                              \
    auto r0 = __builtin_amdgcn_permlane32_swap(a0, b0, false, false); auto r1 = __builtin_amdgcn_permlane32_swap(a1, b1, false, false); \
    u32x4 w = {r0[0], r1[0], r0[1], r1[1]}; OUT = *reinterpret_cast<bf16x8*>(&w); } while (0)
    PK4(p0, 0, pa0); PK4(p0, 8, pa1); PK4(p1, 0, pa2); PK4(p1, 8, pa3);
#undef PK4
}
template <int DQK> __device__ __forceinline__ void qkt(f32x16& p0, f32x16& p1, const char* Ks, const bf16x8* qr, int r32, int hi) {
    p0 = f32x16{}; p1 = f32x16{};
#pragma unroll
    for (int d0 = 0; d0 < DQK / 16; ++d0) { const int cb = (d0 * 16 + hi * 8) * 2;
        const bf16x8 b0 = *reinterpret_cast<const bf16x8*>(Ks + kswz<DQK>(r32, cb));
        const bf16x8 b1 = *reinterpret_cast<const bf16x8*>(Ks + kswz<DQK>(32 + r32, cb));
        p0 = __builtin_amdgcn_mfma_f32_32x32x16_bf16(b0, qr[d0], p0, 0, 0, 0);
        p1 = __builtin_amdgcn_mfma_f32_32x32x16_bf16(b1, qr[d0], p1, 0, 0, 0); }
}
__device__ __forceinline__ int v_st(int k, int c) { const int kk = (k & ~0xC) | ((k & 4) << 1) | ((k & 8) >> 1); return ((kk >> 3) * 4 + (c >> 5)) * 512 + ((kk & 7) * 32 + (c & 31)) * 2; }
__device__ __forceinline__ int v_rd_base(int lane) { return ((lane & 3) << 3) | (((lane >> 2) & 3) << 6) | (((lane >> 4) & 1) << 5) | (((lane >> 5) & 1) << 8); }
constexpr int v_rd_off(int d0, int ks, int half) { return d0 * 512 + ks * 4096 + half * 2048; }
template <int OFF> __device__ __forceinline__ s16x4 tr_read(int vb) {
    s16x4 r; asm volatile("ds_read_b64_tr_b16 %0, %1 offset:%2" : "=&v"(r) : "v"(vb), "i"(OFF) : "memory"); return r;
}
template <int D0> __device__ __forceinline__ void pv_one(f32x16& od, int vb, bf16x8 pa0, bf16x8 pa1, bf16x8 pa2, bf16x8 pa3) {
    const s16x4 l0 = tr_read<v_rd_off(D0, 0, 0)>(vb), h0 = tr_read<v_rd_off(D0, 0, 1)>(vb), l1 = tr_read<v_rd_off(D0, 1, 0)>(vb), h1 = tr_read<v_rd_off(D0, 1, 1)>(vb);
    const s16x4 l2 = tr_read<v_rd_off(D0, 2, 0)>(vb), h2 = tr_read<v_rd_off(D0, 2, 1)>(vb), l3 = tr_read<v_rd_off(D0, 3, 0)>(vb), h3 = tr_read<v_rd_off(D0, 3, 1)>(vb);
    asm volatile("s_waitcnt lgkmcnt(0)" ::: "memory"); SBAR();
#define PK(L, H) (bf16x8){L[0], L[1], L[2], L[3], H[0], H[1], H[2], H[3]}
    od = __builtin_amdgcn_mfma_f32_32x32x16_bf16(pa0, PK(l0, h0), od, 0, 0, 0);
    od = __builtin_amdgcn_mfma_f32_32x32x16_bf16(pa1, PK(l1, h1), od, 0, 0, 0);
    od = __builtin_amdgcn_mfma_f32_32x32x16_bf16(pa2, PK(l2, h2), od, 0, 0, 0);
    od = __builtin_amdgcn_mfma_f32_32x32x16_bf16(pa3, PK(l3, h3), od, 0, 0, 0);
#undef PK
}
__device__ __forceinline__ void pv_d0(f32x16* o, int vb, bf16x8 pa0, bf16x8 pa1, bf16x8 pa2, bf16x8 pa3) {
    pv_one<0>(o[0], vb, pa0, pa1, pa2, pa3); pv_one<1>(o[1], vb, pa0, pa1, pa2, pa3); pv_one<2>(o[2], vb, pa0, pa1, pa2, pa3); pv_one<3>(o[3], vb, pa0, pa1, pa2, pa3);
}

constexpr int SHM_V = 16384, SHM_K64 = 8192, DA_LDS = 2 * SHM_V + 2 * SHM_K64 + 8 * 256;
__device__ __forceinline__ void diff_pass(const bf16_t* __restrict__ Qb, const bf16_t* __restrict__ Kh, const bf16_t* __restrict__ Vh, int seq, char* lds, f32x16 (&o)[4]) {
    int tid_ = threadIdx.x; asm volatile("" : "+v"(tid_));
    const int tid = tid_, wid = tid >> 6, lane = tid & 63, r32 = lane & 31, hi = lane >> 5;
    char* V_lds = lds; char* K_lds = lds + 2 * SHM_V;
    float* ws = (float*)(lds + 2 * SHM_V + 2 * SHM_K64) + wid * 64; float* li_l = ws; float* al_l = ws + 32;
    float m_reg = -1e30f, l_reg = 0;
#pragma unroll
    for (int d = 0; d < 4; ++d) o[d] = f32x16{};
    bf16x8 qr[4];
    const bf16_t* Qw = Qb + (size_t)(wid * 32 + r32) * DM + hi * 8;
#pragma unroll
    for (int d0 = 0; d0 < 4; ++d0) qr[d0] = *reinterpret_cast<const bf16x8*>(Qw + d0 * 16);
    const int sr = tid >> 4, sc = (tid & 15) * 8, vst0 = v_st(sr, sc), vst1 = v_st(32 + sr, sc);
    const int kr = tid >> 3, kc = (tid & 7) * 8, kst = kswz<64>(kr, kc * 2);
    const int vb0 = (int)(uintptr_t)V_lds + v_rd_base(lane);
    struct { bf16x8 vs0, vs1, ks; } sr_[2];
#define SLOAD(i, k0) do { sr_[i].vs0 = *reinterpret_cast<const bf16x8*>(&Vh[(size_t)((k0) + sr) * DM + sc]); sr_[i].vs1 = *reinterpret_cast<const bf16x8*>(&Vh[(size_t)((k0) + 32 + sr) * DM + sc]); \
    sr_[i].ks = *reinterpret_cast<const bf16x8*>(&Kh[(size_t)((k0) + kr) * DM + kc]); } while (0)
#define SWRITE(b, i) do { *(bf16x8*)(V_lds + (b) * SHM_V + vst0) = sr_[i].vs0; *(bf16x8*)(V_lds + (b) * SHM_V + vst1) = sr_[i].vs1; \
    *(bf16x8*)(K_lds + (b) * SHM_K64 + kst) = sr_[i].ks; } while (0)
#define SWAIT() asm volatile("s_waitcnt vmcnt(3)" ::: "memory")
#define RESC(a) do { if (__any((a) < 1.f)) { if (hi == 0) al_l[r32] = (a); asm volatile("s_waitcnt lgkmcnt(0)" ::: "memory"); \
    _Pragma("unroll") for (int d = 0; d < 4; ++d) _Pragma("unroll") for (int r = 0; r < 16; ++r) o[d][r] *= al_l[crow(r, hi)]; } } while (0)
    f32x16 pA0, pA1, pB0, pB1; float mnA, mnB, alA, alB; bf16x8 pa0, pa1, pa2, pa3; const int NT = seq / 64;
    __syncthreads();
    SLOAD(0, 0); asm volatile("s_waitcnt vmcnt(0)" ::: "memory"); SWRITE(0, 0); __syncthreads();
    qkt<64>(pA0, pA1, K_lds, qr, r32, hi); partialSM(pA0, pA1, m_reg, mnA, alA);
    SLOAD(1, 64); if (2 < NT) SLOAD(0, 128);
    SWAIT(); SWRITE(1, 1); __syncthreads();
    for (int j = 1; j + 1 < NT; j += 2) {
        SBAR(); qkt<64>(pB0, pB1, K_lds + SHM_K64, qr, r32, hi);
        finishSM(pA0, pA1, alA, l_reg, pa0, pa1, pa2, pa3); SBAR();
        SLOAD(1, (j + 2) * 64); SBAR();
        pv_d0(o, vb0, pa0, pa1, pa2, pa3); partialSM(pB0, pB1, m_reg, mnB, alB);
        __syncthreads(); SWAIT(); SWRITE(0, 0);
        RESC(alB); __syncthreads();
        SBAR(); qkt<64>(pA0, pA1, K_lds, qr, r32, hi);
        finishSM(pB0, pB1, alB, l_reg, pa0, pa1, pa2, pa3); SBAR();
        if (j + 3 < NT) SLOAD(0, (j + 3) * 64); SBAR();
        pv_d0(o, vb0 + SHM_V, pa0, pa1, pa2, pa3); partialSM(pA0, pA1, m_reg, mnA, alA);
        __syncthreads(); SWAIT(); SWRITE(1, 1);
        RESC(alA); __syncthreads();
    }
    SBAR(); qkt<64>(pB0, pB1, K_lds + SHM_K64, qr, r32, hi);
    finishSM(pA0, pA1, alA, l_reg, pa0, pa1, pa2, pa3); SBAR();
    pv_d0(o, vb0, pa0, pa1, pa2, pa3); partialSM(pB0, pB1, m_reg, mnB, alB);
    __syncthreads(); RESC(alB);
    finishSM(pB0, pB1, alB, l_reg, pa0, pa1, pa2, pa3); SBAR();
    pv_d0(o, vb0 + SHM_V, pa0, pa1, pa2, pa3);
    if (hi == 0) li_l[r32] = l_reg; asm volatile("s_waitcnt lgkmcnt(0)" ::: "memory");
#pragma unroll
    for (int r = 0; r < 16; ++r) { const float rl = __builtin_amdgcn_rcpf(li_l[crow(r, hi)]);
#pragma unroll
        for (int d = 0; d < 4; ++d) o[d][r] *= rl; }
#undef SLOAD
#undef SWRITE
#undef SWAIT
#undef RESC
}

__device__ __forceinline__ void diff_unit(int b, int h, int qb, const bf16_t* Q, const bf16_t* K, const bf16_t* V, bf16_t* YA, float lam, float omli, const float* subln, char* lds) {
    int tid_ = threadIdx.x; asm volatile("" : "+v"(tid_));
    const int tid = tid_, wid = tid >> 6, lane = tid & 63, r32 = lane & 31, hi = lane >> 5;
    const size_t rowbase = (size_t)b * SEQ; const int q0 = qb * 256;
    const bf16_t* Qb = Q + (rowbase + q0) * DM + h * 128;
    const bf16_t* Kh = K + rowbase * DM + h * 128;
    const bf16_t* Vh = V + rowbase * DM + h * 128;
    f32x16 o[4];
    diff_pass(Qb, Kh, Vh, SEQ, lds, o);
    unsigned* park = (unsigned*)(lds + DA_LDS) + wid * 2048 + lane;
#pragma unroll
    for (int d = 0; d < 4; ++d)
#pragma unroll
        for (int r = 0; r < 8; ++r) park[(d * 8 + r) * 64] = cvt_pk_bf16(o[d][2 * r], o[d][2 * r + 1]);
    diff_pass(Qb + 64, Kh + 64, Vh, SEQ, lds, o);
    asm volatile("s_waitcnt lgkmcnt(0)" ::: "memory");
    float ss[16];
#pragma unroll
    for (int r = 0; r < 16; ++r) { float s = 0.f;
#pragma unroll
        for (int d = 0; d < 4; ++d) { const unsigned pw = park[(d * 8 + (r >> 1)) * 64]; const float a = (r & 1) ? bf_hi(pw) : bf_lo(pw); const float v = a - lam * o[d][r]; o[d][r] = v; s += v * v; }
        ss[r] = s; }
#pragma unroll
    for (int r = 0; r < 16; ++r) {
        ss[r] = sum32(ss[r]);
        ss[r] = omli / sqrtf(ss[r] * (1.0f / 128.0f) + EPS); }
    float gl[4];
#pragma unroll
    for (int d = 0; d < 4; ++d) gl[d] = subln[32 * d + r32];
    bf16_t* Ow = YA + (rowbase + q0 + wid * 32) * DM + h * 128 + r32;
#pragma unroll
    for (int r = 0; r < 16; ++r) { const int orow = crow(r, hi);
#pragma unroll
        for (int d = 0; d < 4; ++d) Ow[(size_t)orow * DM + 32 * d] = (bf16_t)(cvt_pk_bf16(o[d][r] * ss[r] * gl[d], 0.f) & 0xffffu); }
}

constexpr int CA_LDS = 32768 + 32768 + 8 * 256;
__device__ __forceinline__ void cross_unit(int b, int hd, int qb, const bf16_t* QC, const bf16_t* KV, bf16_t* OC, char* lds) {
    int tid_ = threadIdx.x; asm volatile("" : "+v"(tid_));
    const int tid = tid_, wid = tid >> 6, lane = tid & 63, r32 = lane & 31, hi = lane >> 5, vimg = wid >> 2;
    char* K_lds = lds; char* V_lds = lds + 32768; float* ws = (float*)(lds + 65536) + wid * 64; float* li_l = ws; float* al_l = ws + 32;
    const size_t qrow = (size_t)b * SEQ + qb * 128 + (wid & 3) * 32;
    const bf16_t* Qw = QC + (qrow + r32) * DM + hd * 256 + hi * 8;
    bf16x8 qr[16];
#pragma unroll
    for (int d0 = 0; d0 < 16; ++d0) qr[d0] = *reinterpret_cast<const bf16x8*>(Qw + d0 * 16);
    const bf16_t* Kh = KV + (size_t)(b * NMEM) * 2048 + hd * 256; const bf16_t* Vh = Kh + 1024;
    const int kr = tid >> 3, kc8 = tid & 7, sr = tid >> 4, sc = (tid & 15) * 8, vst0 = v_st(sr, sc), vst1 = v_st(32 + sr, sc);
    const int vb0 = (int)(uintptr_t)V_lds + vimg * SHM_V + v_rd_base(lane);
    float m_reg = -1e30f, l_reg = 0; f32x16 o[4];
#pragma unroll
    for (int d = 0; d < 4; ++d) o[d] = f32x16{};
    for (int t = 0; t < 4; ++t) {
        const int k0 = t * 64;
        __syncthreads();
        { bf16x8 kk[4];
#pragma unroll
          for (int j = 0; j < 4; ++j) kk[j] = *reinterpret_cast<const bf16x8*>(&Kh[(size_t)(k0 + kr) * 2048 + (kc8 + 8 * j) * 8]);
#pragma unroll
          for (int j = 0; j < 4; ++j) *(bf16x8*)(K_lds + kswz<256>(kr, (kc8 + 8 * j) * 16)) = kk[j]; }
        asm volatile("" ::: "memory");
        { bf16x8 vv[4];
          vv[0] = *reinterpret_cast<const bf16x8*>(&Vh[(size_t)(k0 + sr) * 2048 + sc]);       vv[1] = *reinterpret_cast<const bf16x8*>(&Vh[(size_t)(k0 + 32 + sr) * 2048 + sc]);
          vv[2] = *reinterpret_cast<const bf16x8*>(&Vh[(size_t)(k0 + sr) * 2048 + 128 + sc]); vv[3] = *reinterpret_cast<const bf16x8*>(&Vh[(size_t)(k0 + 32 + sr) * 2048 + 128 + sc]);
          *(bf16x8*)(V_lds + vst0) = vv[0]; *(bf16x8*)(V_lds + vst1) = vv[1]; *(bf16x8*)(V_lds + SHM_V + vst0) = vv[2]; *(bf16x8*)(V_lds + SHM_V + vst1) = vv[3]; }
        __syncthreads();
        f32x16 p0, p1; float mn, al; bf16x8 pa0, pa1, pa2, pa3;
        qkt<256>(p0, p1, K_lds, qr, r32, hi); partialSM(p0, p1, m_reg, mn, al);
        if (__any(al < 1.f)) { if (hi == 0) al_l[r32] = al; asm volatile("s_waitcnt lgkmcnt(0)" ::: "memory");
#pragma unroll
            for (int d = 0; d < 4; ++d)
#pragma unroll
                for (int r = 0; r < 16; ++r) o[d][r] *= al_l[crow(r, hi)]; }
        finishSM(p0, p1, al, l_reg, pa0, pa1, pa2, pa3); SBAR();
        pv_d0(o, vb0, pa0, pa1, pa2, pa3);
    }
    if (hi == 0) li_l[r32] = l_reg; asm volatile("s_waitcnt lgkmcnt(0)" ::: "memory");
    bf16_t* Ow = OC + qrow * DM + hd * 256 + vimg * 128 + r32;
#pragma unroll
    for (int r = 0; r < 16; ++r) { const float rl = __builtin_amdgcn_rcpf(li_l[crow(r, hi)]); const int orow = crow(r, hi);
#pragma unroll
        for (int d = 0; d < 4; ++d) Ow[(size_t)orow * DM + 32 * d] = (bf16_t)(cvt_pk_bf16(o[d][r] * rl, 0.f) & 0xffffu); }
    __syncthreads();
}
#undef SBAR
}

__device__ __forceinline__ f32x4 ld_bf4(const bf16_t* p) { const u32x2 w = *(const u32x2*)p; return (f32x4){bf_lo(w.x), bf_hi(w.x), bf_lo(w.y), bf_hi(w.y)}; }
__device__ __forceinline__ void st_bf4(bf16_t* p, f32x4 v) { u32x2 w; w.x = cvt_pk_bf16(v[0], v[1]); w.y = cvt_pk_bf16(v[2], v[3]); *(u32x2*)p = w; }
__device__ __forceinline__ void ld_bf8(const bf16_t* p, f32x4& a, f32x4& b) { const u32x4 w = *(const u32x4*)p; a = (f32x4){bf_lo(w.x), bf_hi(w.x), bf_lo(w.y), bf_hi(w.y)}; b = (f32x4){bf_lo(w.z), bf_hi(w.z), bf_lo(w.w), bf_hi(w.w)}; }

__device__ __forceinline__ void conv_rows(const bf16_t* U, const bf16_t* CB, const float* cw, bf16_t* YC, int gw, int NGW, int lane) {
    for (int g = gw; g < T / 8; g += NGW) { const int t0 = g * 8;
#pragma unroll
        for (int c2 = 0; c2 < 2; ++c2) { const int col = c2 * 512 + lane * 8;
            f32x4 w0a = *(const f32x4*)(cw + col), w0b = *(const f32x4*)(cw + col + 4), w1a = *(const f32x4*)(cw + DM + col), w1b = *(const f32x4*)(cw + DM + col + 4),
                  w2a = *(const f32x4*)(cw + 2 * DM + col), w2b = *(const f32x4*)(cw + 2 * DM + col + 4);
            f32x4 pa = {0.f, 0.f, 0.f, 0.f}, pb = pa, ca, cb_, na, nb;
            if ((t0 & (SEQ - 1)) != 0) ld_bf8(U + (size_t)(t0 - 1) * DM + col, pa, pb);
            ld_bf8(U + (size_t)t0 * DM + col, ca, cb_);
            for (int i = 0; i < 8; ++i) { const int t = t0 + i;
                if (((t + 1) & (SEQ - 1)) != 0) ld_bf8(U + (size_t)(t + 1) * DM + col, na, nb); else { na = (f32x4){0.f, 0.f, 0.f, 0.f}; nb = na; }
                f32x4 ga, gb; ld_bf8(CB + (size_t)t * DM + col, ga, gb);
                st8(YC + (size_t)t * DM + col, ga * (w0a * pa + w1a * ca + w2a * na), gb * (w0b * pb + w1b * cb_ + w2b * nb));
                pa = ca; pb = cb_; ca = na; cb_ = nb; } } }
}
__device__ __forceinline__ void x0_row(const float* xrow, bf16_t* xbrow, float* prow, int lane) {
    const f32x4* xr = (const f32x4*)xrow + lane; float s = 0.f;
#pragma unroll
    for (int j = 0; j < 4; ++j) { const f32x4 v = xr[64 * j]; s += (v[0] * v[0] + v[1] * v[1]) + (v[2] * v[2] + v[3] * v[3]); st_bf4(xbrow + j * 256 + lane * 4, v); }
    s = wave_sum(s);
    if (lane < 16) prow[lane] = lane == 0 ? s : 0.f;
}
__device__ __forceinline__ void memn_row(const float* xrow, const float* g, bf16_t* orow, int lane) {
    const f32x4* xr = (const f32x4*)xrow + lane; const f32x4* gr = (const f32x4*)g + lane; f32x4 v[4]; float s = 0.f;
#pragma unroll
    for (int j = 0; j < 4; ++j) { v[j] = xr[64 * j]; s += (v[j][0] * v[j][0] + v[j][1] * v[j][1]) + (v[j][2] * v[j][2] + v[j][3] * v[j][3]); }
    const float r = 1.0f / sqrtf(wave_sum(s) * (1.0f / DM) + EPS);
#pragma unroll
    for (int j = 0; j < 4; ++j) st_bf4(orow + j * 256 + lane * 4, v[j] * r * gr[64 * j]);
}
__device__ __forceinline__ void combine_row(int t, const LAS int* bst, const int* tok_e, const int* tok_pos, const float* tok_w, const bf16_t* Y, float* xio, bf16_t* xb, float* part, const float* gfin, bool last, int lane) {
    const int e0 = tok_e[2 * t], e1 = tok_e[2 * t + 1]; const float w0 = tok_w[2 * t], w1 = tok_w[2 * t + 1];
    const size_t s0 = (size_t)bst[e0] * 256 + tok_pos[2 * t], s1 = (size_t)bst[e1] * 256 + tok_pos[2 * t + 1];
    f32x4 v[4]; float s = 0.f;
#pragma unroll
    for (int j = 0; j < 4; ++j) { const int c = j * 256 + lane * 4;
        v[j] = *(const f32x4*)(xio + (size_t)t * DM + c) + w0 * ld_bf4(Y + s0 * DM + c) + w1 * ld_bf4(Y + s1 * DM + c);
        s += (v[j][0] * v[j][0] + v[j][1] * v[j][1]) + (v[j][2] * v[j][2] + v[j][3] * v[j][3]); }
    s = wave_sum(s);
    if (!last) {
#pragma unroll
        for (int j = 0; j < 4; ++j) { const int c = j * 256 + lane * 4; *(f32x4*)(xio + (size_t)t * DM + c) = v[j]; st_bf4(xb + (size_t)t * DM + c, v[j]); }
        if (lane < 16) part[(size_t)t * 16 + lane] = lane == 0 ? s : 0.f;
    } else {
        const float r = 1.0f / sqrtf(s * (1.0f / DM) + EPS);
#pragma unroll
        for (int j = 0; j < 4; ++j) { const int c = j * 256 + lane * 4; *(f32x4*)(xio + (size_t)t * DM + c) = v[j] * r * *(const f32x4*)(gfin + c); }
    }
}
__device__ __forceinline__ void route_token(int t, const float* x, const float* part, const float (&gf)[16], const f32x4 (&wg)[16], const LAS char* WeL,
                                            unsigned* ecnt, int* elist, int* tok_e, int* tok_pos, float* tok_w, int lane) {
    float pp = lane < 16 ? part[(size_t)t * 16 + lane] : 0.f; pp = wave_sum(pp);
    const float rs = 1.0f / sqrtf(pp * (1.0f / DM) + EPS);
    float hv[16]; f32x4 ag = {0.f, 0.f, 0.f, 0.f};
#pragma unroll
    for (int j = 0; j < 16; ++j) { hv[j] = x[(size_t)t * DM + j * 64 + lane] * rs * gf[j]; ag += hv[j] * wg[j]; }
    float a0 = wave_sum(ag[0]), a1 = wave_sum(ag[1]), a2 = wave_sum(ag[2]), a3 = wave_sum(ag[3]);
    int gi = 0; float am = a0; if (a1 > am) { am = a1; gi = 1; } if (a2 > am) { am = a2; gi = 2; } if (a3 > am) { am = a3; gi = 3; }
    const float gw_ = 1.0f / (__expf(a0 - am) + __expf(a1 - am) + __expf(a2 - am) + __expf(a3 - am));
    gi = __builtin_amdgcn_readfirstlane(gi);
    f32x4 ea = {0.f, 0.f, 0.f, 0.f}, eb = ea;
#pragma unroll
    for (int j = 0; j < 16; ++j) { const int k = j * 64 + lane; const int sw = (k >> 1) & 7;
        const f32x4 wa = *(const LAS f32x4*)(WeL + k * 128 + (((2 * gi) ^ sw) << 4)), wb = *(const LAS f32x4*)(WeL + k * 128 + (((2 * gi + 1) ^ sw) << 4));
        ea += hv[j] * wa; eb += hv[j] * wb; }
    float e[8];
#pragma unroll
    for (int q = 0; q < 4; ++q) { e[q] = wave_sum(ea[q]); e[4 + q] = wave_sum(eb[q]); }
    int i1 = 0; float e1v = e[0];
#pragma unroll
    for (int q = 1; q < 8; ++q) if (e[q] > e1v) { e1v = e[q]; i1 = q; }
    int i2 = (i1 == 0) ? 1 : 0; float e2v = -3.0e38f;
#pragma unroll
    for (int q = 0; q < 8; ++q) if (q != i1 && e[q] > e2v) { e2v = e[q]; i2 = q; }
    const float z = __expf(e2v - e1v); const float w1 = gw_ / (1.0f + z), w2 = gw_ * z / (1.0f + z);
    if (lane == 0) {
        const int x1 = gi * 8 + i1, x2 = gi * 8 + i2;
        const int p1 = (int)atomicAdd(ecnt + x1 * 64, 1u), p2 = (int)atomicAdd(ecnt + x2 * 64, 1u);
        elist[(size_t)x1 * T + p1] = t; elist[(size_t)x2 * T + p2] = t;
        tok_e[2 * t] = x1; tok_e[2 * t + 1] = x2; tok_pos[2 * t] = p1; tok_pos[2 * t + 1] = p2; tok_w[2 * t] = w1; tok_w[2 * t + 1] = w2;
    }
}

__device__ __forceinline__ int map_row(int mode, int n) {
    if (mode == 1) {
        if (n < 2048) { const int d = n & 63; const int p = (d >= 4 && d < 8) ? d + 4 : (d >= 8 && d < 12) ? d - 4 : d; return (n & ~63) + p; }
        if (n >= 4096 && n < 5120) { const int q = n - 4096; return 4096 + (q >> 7) * 256 + (q & 127); }
        if (n >= 5120 && n < 6144) { const int q = n - 5120; return 4096 + (q >> 7) * 256 + 128 + (q & 127); }
        return n;
    }
    if (mode == 2) return (n >> 7) * 256 + (n & 127);
    if (mode == 3) return (n >> 7) * 256 + 128 + (n & 127);
    return n;
}
__device__ __forceinline__ void transpose_item(const float* W, int ldw, int k0, int n0, const float* gain, bf16_t* WT, int ldt, int mode, LAS float* scr, int lane) {
    f32x4 v[16];
#pragma unroll
    for (int i = 0; i < 16; ++i) v[i] = *(const f32x4*)(W + (size_t)(k0 + 4 * i + (lane >> 4)) * ldw + n0 + (lane & 15) * 4);
    if (gain) {
#pragma unroll
        for (int i = 0; i < 16; ++i) v[i] = v[i] * gain[k0 + 4 * i + (lane >> 4)];
    }
#pragma unroll
    for (int i = 0; i < 16; ++i) { LAS float* s = scr + (4 * i + (lane >> 4)) * 65 + (lane & 15) * 4; s[0] = v[i][0]; s[1] = v[i][1]; s[2] = v[i][2]; s[3] = v[i][3]; }
    LDS_WAIT(); asm volatile("" ::: "memory");
    const int c = lane & 7;
#pragma unroll
    for (int j = 0; j < 8; ++j) { const int n = (lane >> 3) + 8 * j; const LAS float* s = scr + (8 * c) * 65 + n;
        u32x4 o; o.x = cvt_pk_bf16(s[0 * 65], s[1 * 65]); o.y = cvt_pk_bf16(s[2 * 65], s[3 * 65]); o.z = cvt_pk_bf16(s[4 * 65], s[5 * 65]); o.w = cvt_pk_bf16(s[6 * 65], s[7 * 65]);
        *(u32x4*)(WT + (size_t)map_row(mode, n0 + n) * ldt + k0 + 8 * c) = o; }
    LDS_WAIT(); asm volatile("" ::: "memory");
}
constexpr int IT_IN = 2048, IT_BR = 512, IT_SQ = 256, IT_KV = 512, IT_EXP = 576, IT_LAYER = IT_IN + IT_BR + 3 * IT_SQ + IT_KV + 32 * IT_EXP;
__device__ __forceinline__ void rope_entry(int idx, float* cosT, float* sinT) {
    const int t = idx >> 3, i = idx & 7;
    const double inv = i == 0 ? 1.0 : i == 1 ? 0.19392274474868576 : i == 2 ? 0.03760603093086393 : i == 3 ? 0.007292664737217109 : i == 4 ? 0.001414213562373095 : i == 5 ? 0.0002742481756762073 : i == 6 ? 5.318295896944988e-05 : 1.031338537721246e-05;
    const double ang = (double)t * inv;
    const double kq = __builtin_rint(ang * 0.6366197723675814);
    const double r = (ang - kq * 1.5707963267341256) - kq * 6.077100506506192e-11;
    const double r2 = r * r;
    double sn = 1.0 / 6227020800.0; sn = sn * r2 - 1.0 / 39916800.0; sn = sn * r2 + 1.0 / 362880.0; sn = sn * r2 - 1.0 / 5040.0; sn = sn * r2 + 1.0 / 120.0; sn = sn * r2 - 1.0 / 6.0; sn = sn * r2 + 1.0; sn = sn * r;
    double cs = 1.0 / 479001600.0; cs = cs * r2 - 1.0 / 3628800.0; cs = cs * r2 + 1.0 / 40320.0; cs = cs * r2 - 1.0 / 720.0; cs = cs * r2 + 1.0 / 24.0; cs = cs * r2 - 0.5; cs = cs * r2 + 1.0;
    const int q = ((int)kq) & 3;
    const double c = q == 0 ? cs : q == 1 ? -sn : q == 2 ? -cs : sn;
    const double s = q == 0 ? sn : q == 1 ? cs : q == 2 ? -sn : -cs;
    cosT[idx] = (float)c; sinT[idx] = (float)s;
}

#define XB_TMO      128
#define XB_XCNT(j)  (256  + 64 * (j))
#define XB_XSUB(j)  (1280 + 64 * (j))
#define XB_XGEN(j)  (2304 + 64 * (j))
#define XB_TOP      3328
#define XB_TOPGEN   3392
#define XCD_BAR_WORDS 3456
#define XB_SPIN_CAP (1u << 18)
__device__ __forceinline__ unsigned xb_ld(unsigned* p)              { return __hip_atomic_load(p, __ATOMIC_RELAXED, __HIP_MEMORY_SCOPE_AGENT); }
__device__ __forceinline__ unsigned xb_add(unsigned* p, unsigned v) { return __hip_atomic_fetch_add(p, v, __ATOMIC_RELAXED, __HIP_MEMORY_SCOPE_AGENT); }
__device__ __forceinline__ unsigned xb_xcc_id() { return (unsigned)__builtin_amdgcn_s_getreg((3 << 11) | 20) & 0xFu; }
#define XB_SPIN(cond, bar) do { unsigned _sp = 0; while (cond) { __builtin_amdgcn_s_sleep(1); \
    if ((++_sp & 255u) == 0u) { if (xb_ld(&(bar)[XB_TMO])) break; if (_sp > XB_SPIN_CAP) { atomicAdd(&(bar)[XB_TMO], 1u); break; } } } } while (0)
struct XcdBarrier { unsigned* bar; unsigned x; volatile LAS unsigned* st; };
__device__ __forceinline__ XcdBarrier xcd_barrier_post(unsigned* bar, volatile LAS unsigned* st) {
    XcdBarrier b; b.bar = bar; b.x = (unsigned)__builtin_amdgcn_readfirstlane((int)xb_xcc_id()); b.st = st;
    if (threadIdx.x == 0) (void)xb_add(&bar[XB_XCNT(b.x)], 1u);
    return b;
}
__device__ __forceinline__ void xcd_barrier_complete(unsigned* bar, unsigned x, unsigned& nloc, unsigned& nx) {
    const unsigned G = gridDim.x * gridDim.y * gridDim.z;
    unsigned sum, cnt, mine, sp = 0u;
    for (;;) {
        sum = 0u; cnt = 0u; mine = 0u;
#pragma unroll
        for (unsigned j = 0; j < 16; ++j) { const unsigned c = xb_ld(&bar[XB_XCNT(j)]); sum += c; cnt += (c > 0u) ? 1u : 0u; mine = (j == x) ? c : mine; }
        if (sum == G) break;
        __builtin_amdgcn_s_sleep(1);
        if ((++sp & 255u) == 0u) { if (xb_ld(&bar[XB_TMO])) break; if (sp > XB_SPIN_CAP) { atomicAdd(&bar[XB_TMO], 1u); break; } }
    }
    nloc = mine > 0u ? mine : 1u; nx = cnt > 0u ? cnt : 1u;
}
__device__ __forceinline__ void xcd_barrier(const XcdBarrier& b) {
    asm volatile("s_waitcnt vmcnt(0)" ::: "memory");
    __syncthreads();
    int t0_ = threadIdx.x; asm volatile("" : "+v"(t0_));
    if (t0_ == 0) {
        unsigned* bar = b.bar; unsigned bx_ = b.x;
        asm volatile("" : "+s"(bar), "+s"(bx_));
        __builtin_amdgcn_s_waitcnt(0);
        unsigned nloc = b.st[0], nx = b.st[1];
        if (nloc == 0u) { xcd_barrier_complete(bar, bx_, nloc, nx); b.st[0] = nloc; b.st[1] = nx; }
        const unsigned old = xb_add(&bar[XB_XSUB(bx_)], 1u);
        const unsigned gen = old / nloc;
        if (old + 1u == (gen + 1u) * nloc) {
            __builtin_amdgcn_fence(__ATOMIC_RELEASE, "agent");
            asm volatile("s_waitcnt vmcnt(0)" ::: "memory");
            const unsigned og = xb_add(&bar[XB_TOP], 1u);
            const unsigned tg = og / nx;
            if (og + 1u == (tg + 1u) * nx) xb_add(&bar[XB_TOPGEN], 1u);
            else XB_SPIN(xb_ld(&bar[XB_TOPGEN]) == tg, bar);
            __builtin_amdgcn_fence(__ATOMIC_ACQUIRE, "agent");
            xb_add(&bar[XB_XGEN(bx_)], 1u);
            asm volatile("s_waitcnt vmcnt(0)" ::: "memory");
        } else {
            XB_SPIN(xb_ld(&bar[XB_XGEN(bx_)]) == gen, bar);
            __builtin_amdgcn_fence(__ATOMIC_ACQUIRE, "agent");
            asm volatile("s_waitcnt vmcnt(0)" ::: "memory");
        }
    }
    __syncthreads();
}

struct Args { const float* in[24]; float* out; unsigned char* ws; int ph_lo, ph_hi; };
enum { I_X = 0, I_MEM, I_NMIX, I_WIN, I_LQ1, I_LK1, I_LQ2, I_LK2, I_SUBLN, I_CONVW, I_WBR, I_WO, I_NCROSS, I_NMEM, I_WCQ, I_WCKV, I_WCO, I_NFFN, I_WRG, I_WRE, I_WG, I_WU, I_WD, I_NFIN };

__global__ void __launch_bounds__(512, 2) fwd(Args args) {
    extern __shared__ __attribute__((aligned(16))) unsigned char lds_raw[];
    LAS unsigned char* lds = (LAS unsigned char*)lds_raw;
    const int tid = threadIdx.x, lane = tid & 63, wave = __builtin_amdgcn_readfirstlane(tid >> 6);
    const int G = gridDim.x, bx = blockIdx.x, vcu = (G % 8 == 0) ? (bx % 8) * (G / 8) + bx / 8 : bx;
    const int gw0 = vcu * 8 + wave, NGW = G * 8;
    unsigned char* ws = args.ws;
    unsigned* ctl = (unsigned*)(ws + WS_CTL);
    for (int u = tid; u < (LDS_BYTES - LDSCTL_OFF) / 4; u += 512) ((LAS unsigned*)(lds + LDSCTL_OFF))[u] = 0u;
    __syncthreads();
    volatile LAS unsigned* MISC = (volatile LAS unsigned*)(lds + LC_MISC);
    LAS int* bst = (LAS int*)(lds + LC_BST); LAS int* cntL = (LAS int*)(lds + LC_CNT); LAS int* bexp = (LAS int*)(lds + LC_BEXP);
#if MK_SPLIT
    XcdBarrier bar; bar.bar = ctl + CW_BAR; bar.x = 0; bar.st = nullptr;
#define GRID_BAR() do { } while (0)
#else
    XcdBarrier bar = xcd_barrier_post(ctl + CW_BAR, MISC + 8);
#define GRID_BAR() xcd_barrier(bar)
#endif
    const int lo = args.ph_lo, hi_ = args.ph_hi; (void)lo; (void)hi_;
#ifndef PH_MASK
#define PH_MASK 0xfff
#endif
#define PEN(j) (((PH_MASK) >> (j)) & 1)
#if MK_SPLIT
#define IN(k) (lo <= (k) && (k) < hi_)
#else
#define IN(k) true
#endif
#define OPQ_LANE() int tid_o_ = threadIdx.x, gw_o_ = gw0; asm volatile("" : "+v"(tid_o_), "+s"(gw_o_)); const int tid = tid_o_, lane = tid_o_ & 63, gw = gw_o_; (void)tid; (void)lane; (void)gw
#define SEAM(k) do { if (IN(k) && IN((k) + 1)) GRID_BAR(); } while (0)
    float* cosT = (float*)(ws + WS_ROPE); float* sinT = cosT + SEQ * 8;
    float* part = (float*)(ws + WS_PART);
    int* tok_e = (int*)(ws + WS_TOK); int* tok_pos = tok_e + 2 * T; float* tok_w = (float*)(tok_pos + 2 * T);
    int* elist = (int*)(ws + WS_ELIST);
    bf16_t* memn = (bf16_t*)(ws + WS_MEMN); bf16_t* KVC = (bf16_t*)(ws + WS_KVC); bf16_t* XB = (bf16_t*)(ws + WS_XB);
    bf16_t* Qb = (bf16_t*)(ws + WS_Q); bf16_t* Kb = (bf16_t*)(ws + WS_K); bf16_t* Vb = (bf16_t*)(ws + WS_V); bf16_t* Ub = (bf16_t*)(ws + WS_U); bf16_t* CBb = (bf16_t*)(ws + WS_CB);
    bf16_t* Gb = (bf16_t*)(ws + WS_G); bf16_t* YA = (bf16_t*)(ws + WS_YA); bf16_t* YC = (bf16_t*)(ws + WS_YC); bf16_t* Mb = (bf16_t*)(ws + WS_M);
    bf16_t* QC = (bf16_t*)(ws + WS_QC); bf16_t* OC = (bf16_t*)(ws + WS_OC); bf16_t* ACT = (bf16_t*)(ws + WS_ACT); bf16_t* Yb = (bf16_t*)(ws + WS_Y);
    float* xs = args.out;

    if (IN(0) && PEN(11)) {
        OPQ_LANE();
        LAS float* scr = (LAS float*)(lds + wave * 16640);
        for (int it = gw; it < NL * IT_LAYER; it += NGW) {
            const int l = it / IT_LAYER; int r = it - l * IT_LAYER; unsigned char* wl = ws + WS_W + (size_t)l * WL_SZ;
            if (r < IT_IN) { transpose_item(args.in[I_WIN] + (size_t)l * DM * INW, INW, (r >> 7) * 64, (r & 127) * 64, args.in[I_NMIX] + l * DM, (bf16_t*)(wl + WL_IN), DM, 1, scr, lane); continue; } r -= IT_IN;
            if (r < IT_BR) { const int n = r >> 8, q = r & 255; transpose_item(args.in[I_WBR] + (size_t)(l * 2 + n) * DM * DM, DM, (q >> 4) * 64, (q & 15) * 64, nullptr, (bf16_t*)(wl + WL_BR) + (size_t)n * DM * DM, DM, 0, scr, lane); continue; } r -= IT_BR;
            if (r < IT_SQ) { transpose_item(args.in[I_WO] + (size_t)l * DM * DM, DM, (r >> 4) * 64, (r & 15) * 64, nullptr, (bf16_t*)(wl + WL_O), DM, 0, scr, lane); continue; } r -= IT_SQ;
            if (r < IT_SQ) { transpose_item(args.in[I_WCQ] + (size_t)l * DM * DM, DM, (r >> 4) * 64, (r & 15) * 64, args.in[I_NCROSS] + l * DM, (bf16_t*)(wl + WL_CQ), DM, 0, scr, lane); continue; } r -= IT_SQ;
            if (r < IT_KV) { transpose_item(args.in[I_WCKV] + (size_t)l * DM * 2048, 2048, (r >> 5) * 64, (r & 31) * 64, nullptr, (bf16_t*)(wl + WL_CKV), DM, 0, scr, lane); continue; } r -= IT_KV;
            if (r < IT_SQ) { transpose_item(args.in[I_WCO] + (size_t)l * DM * DM, DM, (r >> 4) * 64, (r & 15) * 64, nullptr, (bf16_t*)(wl + WL_CO), DM, 0, scr, lane); continue; } r -= IT_SQ;
            const int e = r / IT_EXP, r3 = r - e * IT_EXP, ty = r3 / 192, r4 = r3 - ty * 192;
            if (ty < 2) transpose_item(args.in[ty == 0 ? I_WG : I_WU] + (size_t)(l * NE + e) * DM * DE, DE, (r4 / 12) * 64, (r4 % 12) * 64, args.in[I_NFFN] + l * DM, (bf16_t*)(wl + WL_GU) + (size_t)e * 1536 * DM, DM, 2 + ty, scr, lane);
            else transpose_item(args.in[I_WD] + (size_t)(l * NE + e) * DE * DM, DM, (r4 >> 4) * 64, (r4 & 15) * 64, nullptr, (bf16_t*)(wl + WL_DN) + (size_t)e * DM * DE, DE, 0, scr, lane);
        }
        for (int m = gw; m < MT; m += NGW) memn_row(args.in[I_MEM] + (size_t)m * DM, args.in[I_NMEM], memn + (size_t)m * DM, lane);
        for (int m = gw; m < T; m += NGW) x0_row(args.in[I_X] + (size_t)m * DM, XB + (size_t)m * DM, part + (size_t)m * 16, lane);
        for (int i = vcu * 512 + tid; i < SEQ * 8; i += G * 512) rope_entry(i, cosT, sinT);
    }
    SEAM(0);

    for (int l = 0; l < NL; ++l) {
        const int pb = 1 + NPH_L * l;
        unsigned char* wl = ws + WS_W + (size_t)l * WL_SZ;
        const float* xin = (l == 0) ? args.in[I_X] : xs;
        unsigned* ecnt = ctl + CW_ECNT + l * 32 * 64;
        if (IN(pb + 0) && PEN(0)) {
            { DenseSched S; S.init(XB, wl + WL_IN, T, INW, DM, DM, G, bx);
              EpiIn E{part, cosT, sinT, Qb, Kb, Vb, Ub, CBb, Gb};
              pg8::gemm_phase<EpiIn, DenseSched, false, true>(lds, DM, DM, S, E); }
            if (l == 0) { KvcSched S{(const char*)memn, (const char*)(ws + WS_W + WL_CKV), G, bx};
              EpiPlain E{KVC, 2048, nullptr, 1.0f, (size_t)MT * 2048};
              pg8::gemm_phase<EpiPlain, KvcSched, false, true>(lds, DM, DM, S, E); }
        }
        SEAM(pb + 0);
        if (IN(pb + 1) && PEN(1)) {
            OPQ_LANE();
            conv_rows(Ub, CBb, args.in[I_CONVW] + (size_t)l * 3 * DM, YC, gw, NGW, lane);
            const float s1 = wave_sum(args.in[I_LQ1][l * 64 + lane] * args.in[I_LK1][l * 64 + lane]), s2 = wave_sum(args.in[I_LQ2][l * 64 + lane] * args.in[I_LK2][l * 64 + lane]);
            const float li = lambda_init(l), lam = expf(s1) - expf(s2) + li;
            for (int u = vcu; u < NB * NHD * 8; u += G) { const int bh = u >> 3, qb = u & 7;
                att::diff_unit(bh >> 3, bh & 7, qb, Qb, Kb, Vb, YA, lam, 1.0f - li, args.in[I_SUBLN] + l * 128, (char*)lds_raw); }
            __syncthreads();
        }
        SEAM(pb + 1);
        if (IN(pb + 2) && PEN(2)) {
            BrSched S; S.d.init(YA, wl + WL_BR, T, DM, DM, DM, G, bx); S.A1 = (const char*)YC; S.B1 = (const char*)(wl + WL_BR) + (size_t)DM * DM * 2;
            EpiBr E{Gb, Mb};
            pg8::gemm_phase<EpiBr, BrSched, false, true>(lds, DM, DM, S, E);
        }
        SEAM(pb + 2);
        if (IN(pb + 3) && PEN(3)) {
            DenseSched S; S.init(Mb, wl + WL_O, T, DM, DM, DM, G, bx);
            EpiRes E{xin, xs, XB, part};
            pg8::gemm_phase<EpiRes, DenseSched, false, true>(lds, DM, DM, S, E);
        }
        SEAM(pb + 3);
        if (IN(pb + 4) && PEN(4)) {
            DenseSched S; S.init(XB, wl + WL_CQ, T, DM, DM, DM, G, bx);
            EpiPlain E{QC, DM, part, CQSCALE, 0};
            pg8::gemm_phase<EpiPlain, DenseSched, false, true>(lds, DM, DM, S, E);
        }
        SEAM(pb + 4);
        if (IN(pb + 5) && PEN(5)) {
            for (int u = vcu; u < NB * 4 * 16; u += G) { const int bh = u >> 4, qb = u & 15;
                att::cross_unit(bh >> 2, bh & 3, qb, QC, KVC + (size_t)l * MT * 2048, OC, (char*)lds_raw); }
        }
        SEAM(pb + 5);
        if (IN(pb + 6) && PEN(6)) {
            DenseSched S; S.init(OC, wl + WL_CO, T, DM, DM, DM, G, bx);
            EpiRes E{xs, xs, XB, part};
            pg8::gemm_phase<EpiRes, DenseSched, false, true>(lds, DM, DM, S, E);
        }
        SEAM(pb + 6);
        if (IN(pb + 7) && PEN(7)) {
            OPQ_LANE();
            const float* We = args.in[I_WRE] + (size_t)l * DM * NE;
            for (int i = tid; i < DM * 8; i += 512) { const int k = i >> 3, c = i & 7; *(LAS f32x4*)(lds + k * 128 + ((c ^ ((k >> 1) & 7)) << 4)) = *(const f32x4*)(We + k * 32 + c * 4); }
            float gf[16]; f32x4 wg[16];
#pragma unroll
            for (int j = 0; j < 16; ++j) { gf[j] = args.in[I_NFFN][l * DM + j * 64 + lane]; wg[j] = *(const f32x4*)(args.in[I_WRG] + (size_t)l * DM * 4 + (j * 64 + lane) * 4); }
            __syncthreads();
            for (int t = gw; t < T; t += NGW) route_token(t, xs, part, gf, wg, (const LAS char*)lds, ecnt, elist, tok_e, tok_pos, tok_w, lane);
            __syncthreads();
        }
        SEAM(pb + 7);
        if (IN(pb + 8) || IN(pb + 9) || IN(pb + 10)) {
            OPQ_LANE();
            if (tid < 32) cntL[tid] = (int)__hip_atomic_load(ecnt + tid * 64, __ATOMIC_RELAXED, __HIP_MEMORY_SCOPE_AGENT);
            __syncthreads();
            if (tid == 0) { int a = 0;
#pragma unroll 1
                for (int e = 0; e < 32; ++e) { bst[e] = a; const int nb = (cntL[e] + 255) >> 8;
#pragma unroll 1
                    for (int q = 0; q < nb; ++q) bexp[a + q] = e;
                    a += nb; }
                bst[32] = a; }
            __syncthreads();
        }
        if (IN(pb + 8) && PEN(8)) {
            MoeSched S{bst, cntL, bexp, (const char*)XB, (const char*)(wl + WL_GU), elist, (size_t)1536 * DM * 2, (size_t)256 * DM * 2, 6, G, vcu, true};
            EpiGU E{part, ACT};
            pg8::gemm_phase<EpiGU, MoeSched, true, true>(lds, DM, DM, S, E);
        }
        SEAM(pb + 8);
        if (IN(pb + 9) && PEN(9)) {
            MoeSched S{bst, cntL, bexp, (const char*)ACT, (const char*)(wl + WL_DN), elist, (size_t)DM * DE * 2, (size_t)256 * DE * 2, 4, G, vcu, false};
            EpiPlain E{Yb, DM, nullptr, 1.0f, 0};
            pg8::gemm_phase<EpiPlain, MoeSched, false, true>(lds, DE, DE, S, E);
        }
        SEAM(pb + 9);
        if (IN(pb + 10) && PEN(10)) {
            OPQ_LANE();
            for (int t = gw; t < T; t += NGW) combine_row(t, bst, tok_e, tok_pos, tok_w, Yb, xs, XB, part, args.in[I_NFIN], l == NL - 1, lane);
        }
        SEAM(pb + 10);
    }
#undef IN
#undef SEAM
#undef GRID_BAR
}

extern "C" void kernel_launch(void* const* d_in, const int* in_sizes, int n_in, void* d_out, int out_size, void* d_ws, size_t ws_size, hipStream_t stream) {
    static int grid = 0;
    if (grid == 0) {
        if (n_in != 24 || in_sizes[0] != T * DM || out_size != T * DM || ws_size < WS_END) {
            fprintf(stderr, "kernel_launch: shape mismatch: n_in %d in0 %d out %d ws %zu (need >= %zu); nothing launched\n", n_in, n_in > 0 ? in_sizes[0] : -1, out_size, ws_size, (size_t)WS_END); grid = -1; return; }
        int dev = 0, cus = 0, per_cu = 0;
        if (hipGetDevice(&dev) != hipSuccess || hipDeviceGetAttribute(&cus, hipDeviceAttributeMultiprocessorCount, dev) != hipSuccess) { fprintf(stderr, "kernel_launch: device query failed\n"); grid = -1; return; }
        if (hipFuncSetAttribute((const void*)fwd, hipFuncAttributeMaxDynamicSharedMemorySize, LDS_BYTES) != hipSuccess) { fprintf(stderr, "kernel_launch: hipFuncSetAttribute failed\n"); grid = -1; return; }
        if (hipOccupancyMaxActiveBlocksPerMultiprocessor(&per_cu, (const void*)fwd, 512, LDS_BYTES) != hipSuccess || per_cu < 1)
            fprintf(stderr, "kernel_launch: note: occupancy query reports %d workgroups per CU\n", per_cu);
        (void)hipGetLastError();
        grid = cus;
    }
    if (grid < 0) return;
    if (hipMemsetAsync((char*)d_ws + WS_CTL, 0, CTL_ZERO_BYTES, stream) != hipSuccess) { fprintf(stderr, "kernel_launch: memset failed\n"); return; }
    Args a{};
    for (int i = 0; i < 24; ++i) a.in[i] = (const float*)d_in[i];
    a.out = (float*)d_out; a.ws = (unsigned char*)d_ws;
#if MK_SPLIT
    for (int ph = 0; ph < NPHASE; ++ph) { a.ph_lo = ph; a.ph_hi = ph + 1; hipLaunchKernelGGL(fwd, dim3(grid), dim3(512), LDS_BYTES, stream, a); }
#else
    a.ph_lo = 0; a.ph_hi = NPHASE; hipLaunchKernelGGL(fwd, dim3(grid), dim3(512), LDS_BYTES, stream, a);
#endif
    const hipError_t le = hipPeekAtLastError();
    if (le != hipSuccess) fprintf(stderr, "kernel_launch: launch failed: %s\n", hipGetErrorName(le));
}
```

```cpp
#include <hip/hip_runtime.h>
#include <cstdio>
#include <cstdint>

#ifndef MK_SPLIT
#define MK_SPLIT 0
#endif

#define LAS __attribute__((address_space(3)))
#define GAS __attribute__((address_space(1)))
typedef unsigned short bf16_t;
typedef short bf16x8 __attribute__((ext_vector_type(8)));
typedef short s16x4 __attribute__((ext_vector_type(4)));
typedef float f32x2 __attribute__((ext_vector_type(2)));
typedef float f32x4 __attribute__((ext_vector_type(4)));
typedef float f32x16 __attribute__((ext_vector_type(16)));
typedef unsigned u32x2 __attribute__((ext_vector_type(2)));
typedef unsigned u32x4 __attribute__((ext_vector_type(4)));

constexpr int T = 16384, DM = 1024, NB = 8, SEQ = 2048, NL = 4, NMEM = 256, MT = NB * NMEM;
constexpr int INW = 8192, NE = 32, DE = 768, NHD = 8;
constexpr float EPS = 1e-6f;
constexpr float QSCALE = 0.18033688011112042f;
constexpr float CQSCALE = 0.09016844005556021f;
constexpr int MAXROWS = 40960;
constexpr int NPH_L = 11, NPHASE = 1 + NL * NPH_L;

constexpr size_t MiB = 1u << 20;
constexpr size_t WS_CTL = 0, CTL_ZERO_BYTES = 1 * MiB;
constexpr size_t WS_ROPE = 1 * MiB;
constexpr size_t WS_PART = 2 * MiB;
constexpr size_t WS_TOK = 3 * MiB;
constexpr size_t WS_ELIST = 4 * MiB;
constexpr size_t WS_MEMN = 6 * MiB;
constexpr size_t WS_KVC = 10 * MiB;
constexpr size_t WS_XB = 42 * MiB;
constexpr size_t WS_Q = 74 * MiB, WS_K = 106 * MiB, WS_V = 138 * MiB, WS_U = 170 * MiB, WS_CB = 202 * MiB;
constexpr size_t WS_G = 234 * MiB;
constexpr size_t WS_YA = 298 * MiB, WS_YC = 330 * MiB, WS_M = 362 * MiB;
constexpr size_t WS_QC = WS_Q, WS_OC = WS_K;
constexpr size_t WS_ACT = 394 * MiB;
constexpr size_t WS_Y = 454 * MiB;
constexpr size_t WS_W = 534 * MiB;
constexpr size_t WL_IN = 0, WL_BR = 16 * MiB, WL_O = 20 * MiB, WL_CQ = 22 * MiB, WL_CKV = 24 * MiB, WL_CO = 28 * MiB, WL_GU = 30 * MiB, WL_DN = 126 * MiB, WL_SZ = 174 * MiB;
constexpr size_t WS_END = WS_W + NL * WL_SZ;
constexpr int CW_BAR = 4096;
constexpr int CW_ECNT = 16384;

constexpr int RING_BYTES = 131072;
constexpr int LDSCTL_OFF = 145408;
constexpr int LDS_BYTES = 147456;
constexpr int LC_MISC = LDSCTL_OFF;
constexpr int LC_BST = LDSCTL_OFF + 256, LC_CNT = LDSCTL_OFF + 512, LC_BEXP = LDSCTL_OFF + 1024;

__device__ __forceinline__ unsigned cvt_pk_bf16(float lo, float hi) { unsigned r; asm volatile("v_cvt_pk_bf16_f32 %0, %1, %2" : "=v"(r) : "v"(lo), "v"(hi)); return r; }
__device__ __forceinline__ float bf_lo(unsigned w) { return __uint_as_float(w << 16); }
__device__ __forceinline__ float bf_hi(unsigned w) { return __uint_as_float(w & 0xffff0000u); }
template <int M> __device__ __forceinline__ float swz_xor(float v) { return __int_as_float(__builtin_amdgcn_ds_swizzle(__float_as_int(v), (M << 10) | 0x1f)); }
__device__ __forceinline__ float half_sum(float v) { auto rr = __builtin_amdgcn_permlane32_swap(__float_as_uint(v), __float_as_uint(v), false, false); return __uint_as_float(rr[0]) + __uint_as_float(rr[1]); }
__device__ __forceinline__ float sum32(float v) { v += swz_xor<1>(v); v += swz_xor<2>(v); v += swz_xor<4>(v); v += swz_xor<8>(v); v += swz_xor<16>(v); return v; }
__device__ __forceinline__ float wave_sum(float v) { return half_sum(sum32(v)); }
#define LDS_WAIT() asm volatile("s_waitcnt lgkmcnt(0)" ::: "memory")
#define VM_WAIT() asm volatile("s_waitcnt vmcnt(0)" ::: "memory")
__device__ __forceinline__ float lambda_init(int l) { return l == 0 ? 0.2f : l == 1 ? 0.35550906759096934f : l == 2 ? 0.4707130183435842f : 0.5560582041556406f; }
__device__ __forceinline__ float row_rscale(const float* part, int row) {
    const f32x4* p = (const f32x4*)(part + (size_t)row * 16);
    const f32x4 a = p[0], b = p[1], c = p[2], d = p[3];
    const float s = ((a[0] + a[1]) + (a[2] + a[3])) + ((b[0] + b[1]) + (b[2] + b[3])) + (((c[0] + c[1]) + (c[2] + c[3])) + ((d[0] + d[1]) + (d[2] + d[3])));
    return 1.0f / sqrtf(s * (1.0f / DM) + EPS);
}

namespace pg8 {
constexpr int BM = 256, BK = 64, HALF = 128, HTB = HALF * BK * 2, STAGE_BYTES = 8 * HTB;
__host__ __device__ __forceinline__ int lds_byte(int r, int c) { const int st = (r >> 4) * 2 + (c >> 5), rr = r & 15, cc = c & 31, ob = rr * 64 + cc * 2; return st * 1024 + (ob ^ (((ob >> 9) & 1) << 5)); }
__host__ __device__ __forceinline__ void stage_rc(int b, int& R, int& C) { const int st = b / 1024, sb = b % 1024, swz = sb ^ (((sb >> 9) & 1) << 5); R = (st >> 1) * 16 + swz / 64; C = (st & 1) * 32 + (swz % 64) / 2; }
__host__ __device__ __forceinline__ int perm32(int rho) { const int n = rho >> 4, i = rho & 15; return 8 * (i >> 2) + 4 * n + (i & 3); }

struct Unit { const char* A; const char* B; const int* gidx; int pm, pn, aux, nvalid; };

template <class Epi, class Sched, bool GATHER, bool ALIGN_EPI>
__device__ __forceinline__ void gemm_phase(LAS unsigned char* lds, const int K, const int lda, const Sched& S, const Epi& E) {
    int tid_ = threadIdx.x; asm volatile("" : "+v"(tid_));
    const int tid = tid_, wid = __builtin_amdgcn_readfirstlane(tid >> 6), lane = tid & 63, wr = wid >> 2, wc = wid & 3, fr = lane & 15, fq = lane >> 4;
    const int nt = K / BK;
    constexpr int NH = GATHER ? 2 : 1;
    unsigned voffB[2], voffA[NH][2], voffAn[NH][2];
#pragma unroll
    for (int i = 0; i < 2; ++i) { int R, C; stage_rc(tid * 16 + i * 8192, R, C); const int Rb = Epi::PERM ? ((R & ~31) + perm32(R & 31)) : R;
        voffB[i] = (unsigned)(Rb * K + C) * 2u; if constexpr (!GATHER) voffA[0][i] = (unsigned)(R * lda + C) * 2u; }
    const size_t kstep = (size_t)(BK * 2);
    const size_t hstepB = (size_t)HALF * K * 2, hstepA = GATHER ? 0 : (size_t)HALF * lda * 2;
    const unsigned ldsw = (unsigned)wid * 1024u;
    const int aoff = lds_byte(wr * 64 + fr, fq * 8), boff = lds_byte(wc * 32 + fr, fq * 8);
#define PG8_SA(b, h) (((b) * 2 + (h)) * HTB)
#define PG8_SB(b, h) ((4 + (b) * 2 + (h)) * HTB)
#define PG8_STAGE(bufoff, gbase, voff) do { _Pragma("unroll") for (int _i = 0; _i < 2; ++_i) \
        __builtin_amdgcn_global_load_lds((const unsigned*)((const char*)(gbase) + (voff)[_i]), (LAS unsigned*)(lds + (bufoff) + ldsw + _i * 8192), 16, 0, 0); } while (0)
#define PG8_STAGE_A(bufoff, gbase, h, nx) do { if constexpr (GATHER) { unsigned _v[2]; _v[0] = (nx) ? voffAn[h][0] : voffA[h][0]; _v[1] = (nx) ? voffAn[h][1] : voffA[h][1]; PG8_STAGE(bufoff, gbase, _v); } \
        else PG8_STAGE(bufoff, (gbase) + (h) * hstepA, voffA[0]); } while (0)
#define PG8_LDA(dst, b, h) do { _Pragma("unroll") for (int m = 0; m < 4; ++m) _Pragma("unroll") for (int k = 0; k < 2; ++k) dst[m][k] = *(const LAS bf16x8*)(lds + PG8_SA(b, h) + aoff + m * 2048 + k * 1024); } while (0)
#define PG8_LDB(dst, b, h) do { _Pragma("unroll") for (int n = 0; n < 2; ++n) _Pragma("unroll") for (int k = 0; k < 2; ++k) dst[n][k] = *(const LAS bf16x8*)(lds + PG8_SB(b, h) + boff + n * 2048 + k * 1024); } while (0)
#define PG8_MMA(ai, bj, At, Bt) do { __builtin_amdgcn_s_setprio(1); _Pragma("unroll") for (int m = 0; m < 4; ++m) _Pragma("unroll") for (int n = 0; n < 2; ++n) _Pragma("unroll") for (int k = 0; k < 2; ++k) \
        acc[ai][bj][m][n] = __builtin_amdgcn_mfma_f32_16x16x32_bf16(Bt[n][k], At[m][k], acc[ai][bj][m][n], 0, 0, 0); __builtin_amdgcn_s_setprio(0); } while (0)
#define PG8_WAIT_V(n) asm volatile("s_waitcnt vmcnt(" #n ")" ::: "memory")
#define PG8_WAIT_L(n) asm volatile("s_waitcnt lgkmcnt(" #n ")" ::: "memory")
#define PG8_BAR __builtin_amdgcn_s_barrier()
#define PG8_SCHED __builtin_amdgcn_sched_barrier(0)
#define PG8_VOFFA(dst, u) do { if constexpr (GATHER) { _Pragma("unroll") for (int _h = 0; _h < 2; ++_h) _Pragma("unroll") for (int _i = 0; _i < 2; ++_i) { \
        int _R, _C; stage_rc(tid * 16 + _i * 8192, _R, _C); const int _r = _h * HALF + _R; const int _t = (_r < (u).nvalid) ? (u).gidx[_r] : 0; dst[_h][_i] = (unsigned)(_t * lda + _C) * 2u; } } } while (0)
    Unit cur, nxt; int ui = 0;
    if (!S.next(0, cur)) return;
    PG8_VOFFA(voffA, cur);
    f32x4 acc[2][2][4][2];
#pragma unroll
    for (int a = 0; a < 2; ++a)
#pragma unroll
        for (int b = 0; b < 2; ++b)
#pragma unroll
            for (int m = 0; m < 4; ++m)
#pragma unroll
                for (int n = 0; n < 2; ++n) acc[a][b][m][n] = (f32x4){0.f, 0.f, 0.f, 0.f};
    bf16x8 At[4][2], B0[2][2], B1[2][2];
    const char* cA = cur.A; const char* cB = cur.B;
    PG8_STAGE(PG8_SB(0, 0), cB, voffB); PG8_STAGE(PG8_SB(0, 1), cB + hstepB, voffB); PG8_STAGE_A(PG8_SA(0, 0), cA, 0, false); PG8_STAGE_A(PG8_SA(0, 1), cA, 1, false);
    if (wr == 1) PG8_BAR;
    PG8_WAIT_V(2); PG8_BAR;
    PG8_STAGE(PG8_SB(1, 0), cB + kstep, voffB); PG8_STAGE_A(PG8_SA(1, 0), cA + kstep, 0, false); PG8_STAGE(PG8_SB(1, 1), cB + hstepB + kstep, voffB);
    PG8_WAIT_V(6); PG8_BAR;
    for (;;) {
        const bool has_next = S.next(ui + 1, nxt);
        if constexpr (GATHER) {
            if (has_next) { PG8_VOFFA(voffAn, nxt); }
            else {
#pragma unroll
                for (int h = 0; h < NH; ++h)
#pragma unroll
                    for (int i = 0; i < 2; ++i) voffAn[h][i] = voffA[h][i];
            }
        }
        const char* nA = has_next ? nxt.A : cA; const char* nB = has_next ? nxt.B : cB;
        for (int t = 0; t < nt; t += 2) {
            const bool last = (t == nt - 2);
            const char* a1 = cA + (size_t)(t + 1) * kstep;
            const char* a2 = last ? nA : cA + (size_t)(t + 2) * kstep; const char* b2 = last ? nB : cB + (size_t)(t + 2) * kstep;
            const char* a3 = a2 + kstep; const char* b3 = b2 + kstep;
            PG8_LDB(B0, 0, 0); PG8_LDB(B1, 0, 1); PG8_SCHED; PG8_LDA(At, 0, 0); PG8_STAGE_A(PG8_SA(1, 1), a1, 1, false);
            PG8_WAIT_V(8); PG8_WAIT_L(0); PG8_BAR; PG8_MMA(0, 0, At, B0); PG8_MMA(0, 1, At, B1); PG8_BAR; PG8_SCHED;
            PG8_LDA(At, 0, 1); PG8_STAGE(PG8_SB(0, 0), b2, voffB); PG8_STAGE(PG8_SB(0, 1), b2 + hstepB, voffB); PG8_STAGE_A(PG8_SA(0, 0), a2, 0, last);
            PG8_WAIT_V(8); PG8_WAIT_L(0); PG8_BAR; PG8_MMA(1, 0, At, B0); PG8_MMA(1, 1, At, B1); PG8_BAR; PG8_SCHED;
            PG8_LDB(B0, 1, 0); PG8_LDB(B1, 1, 1); PG8_SCHED; PG8_LDA(At, 1, 0); PG8_STAGE_A(PG8_SA(0, 1), a2, 1, last);
            PG8_WAIT_V(8); PG8_WAIT_L(0); PG8_BAR; PG8_MMA(0, 0, At, B0); PG8_MMA(0, 1, At, B1); PG8_BAR; PG8_SCHED;
            PG8_LDA(At, 1, 1); PG8_STAGE(PG8_SB(1, 0), b3, voffB); PG8_STAGE(PG8_SB(1, 1), b3 + hstepB, voffB); PG8_STAGE_A(PG8_SA(1, 0), a3, 0, last);
            PG8_WAIT_V(8); PG8_WAIT_L(0); PG8_BAR; PG8_MMA(1, 0, At, B0); PG8_MMA(1, 1, At, B1); PG8_BAR; PG8_SCHED;
        }
        if constexpr (ALIGN_EPI) { if (wr == 0) PG8_BAR; }
        const bool keep = E(acc, cur, wr, wc, fr, fq);
        if (!has_next) break;
        if (!keep) {
#pragma unroll
            for (int a = 0; a < 2; ++a)
#pragma unroll
                for (int b = 0; b < 2; ++b)
#pragma unroll
                    for (int m = 0; m < 4; ++m)
#pragma unroll
                        for (int n = 0; n < 2; ++n) acc[a][b][m][n] = (f32x4){0.f, 0.f, 0.f, 0.f};
        }
        cur = nxt; cA = nA; cB = nB; ++ui;
        if constexpr (GATHER) {
#pragma unroll
            for (int h = 0; h < NH; ++h)
#pragma unroll
                for (int i = 0; i < 2; ++i) voffA[h][i] = voffAn[h][i];
        }
        if constexpr (ALIGN_EPI) { if (wr == 1) PG8_BAR; }
    }
    PG8_WAIT_V(0);
    if constexpr (!ALIGN_EPI) { if (wr == 0) PG8_BAR; }
    PG8_BAR;
#undef PG8_SA
#undef PG8_SB
#undef PG8_STAGE
#undef PG8_STAGE_A
#undef PG8_LDA
#undef PG8_LDB
#undef PG8_MMA
#undef PG8_WAIT_V
#undef PG8_WAIT_L
#undef PG8_BAR
#undef PG8_SCHED
#undef PG8_VOFFA
}
}

struct DenseSched {
    const char* A; const char* B; size_t astep, bstep; int nM, nN, nwg, G, c;
    __device__ __forceinline__ void init(const void* A_, const void* B_, int M, int N, int K, int lda, int G_, int c_) {
        A = (const char*)A_; B = (const char*)B_; astep = (size_t)256 * lda * 2; bstep = (size_t)256 * K * 2; nM = M / 256; nN = N / 256; nwg = nM * nN; G = G_; c = c_; }
    __device__ __forceinline__ bool next(int i, pg8::Unit& u) const {
        const long L = (long)i * G + c; if (L >= nwg) return false;
        int wgid = (int)L; { const int q = nwg / 8, r = nwg % 8, xcd = wgid % 8, off = wgid / 8; wgid = (xcd < r ? xcd * (q + 1) : r * (q + 1) + (xcd - r) * q) + off; }
        const int nig = 8 * nN, gid = wgid / nig, fm = gid * 8, gsz = (nM - fm) < 8 ? (nM - fm) : 8;
        u.pm = fm + ((wgid % nig) % gsz); u.pn = (wgid % nig) / gsz; u.aux = 0; u.gidx = nullptr; u.nvalid = 256;
        u.A = A + (size_t)u.pm * astep; u.B = B + (size_t)u.pn * bstep; return true;
    }
};
struct BrSched {
    DenseSched d; const char* A1; const char* B1;
    __device__ __forceinline__ bool next(int i, pg8::Unit& u) const {
        if (!d.next(i >> 1, u)) return false;
        if (i & 1) { u.A = A1 + (size_t)u.pm * d.astep; u.B = B1 + (size_t)u.pn * d.bstep; u.aux = 1; }
        return true;
    }
};
struct KvcSched {
    const char* A; const char* B; int G, c;
    __device__ __forceinline__ bool next(int i, pg8::Unit& u) const {
        const int L = i * G + c; if (L >= 256) return false;
        const int l = L >> 6, r = L & 63; u.pm = r & 7; u.pn = r >> 3; u.aux = l; u.gidx = nullptr; u.nvalid = 256;
        u.A = A + (size_t)u.pm * (256 * DM * 2); u.B = B + (size_t)l * WL_SZ + (size_t)u.pn * (256 * DM * 2); return true;
    }
};
struct MoeSched {
    const LAS int* bst; const LAS int* cnt; const LAS int* bexp; const char* A; const char* B; const int* elist; size_t estride, tstride; int ntile, G, c; bool gather;
    __device__ __forceinline__ bool next(int i, pg8::Unit& u) const {
        const int nblk = bst[32]; const int L = i * G + c; if (L >= nblk * ntile) return false;
        const int blk = L / ntile, j = L - blk * ntile;
        const int e = __builtin_amdgcn_readfirstlane(bexp[blk]);
        const int rb = blk - __builtin_amdgcn_readfirstlane(bst[e]); const int ce = __builtin_amdgcn_readfirstlane(cnt[e]);
        u.pm = blk; u.pn = j; u.aux = e; u.nvalid = (ce - rb * 256) < 256 ? (ce - rb * 256) : 256;
        u.gidx = elist + (size_t)e * T + rb * 256;
        u.A = gather ? A : A + (size_t)blk * 256 * DE * 2;
        u.B = B + (size_t)e * estride + (size_t)j * tstride; return true;
    }
};

__device__ __forceinline__ void st8(bf16_t* p, f32x4 v0, f32x4 v1) {
    u32x4 w; w.x = cvt_pk_bf16(v0[0], v0[1]); w.y = cvt_pk_bf16(v0[2], v0[3]); w.z = cvt_pk_bf16(v1[0], v1[1]); w.w = cvt_pk_bf16(v1[2], v1[3]); *(u32x4*)p = w; }
__device__ __forceinline__ float sigmoidf_(float x) { return 1.0f / (1.0f + __expf(-x)); }

struct EpiIn {
    static constexpr bool PERM = true;
    const float* part; const float* cosT; const float* sinT; bf16_t *Q, *Kb, *V, *U, *CB, *G;
    __device__ __forceinline__ bool operator()(f32x4 (&acc)[2][2][4][2], const pg8::Unit& u, int wr, int wc, int fr, int fq) const {
        const int pn = u.pn, row0 = u.pm * 256 + wr * 64 + fr;
#define RS_AT(ai, m) row_rscale(part, row0 + (ai) * 128 + (m) * 16)
#define EFENCE() asm volatile("" ::: "memory")
        if (pn < 8) {
            bf16_t* dst = pn < 4 ? Q : Kb; const float sc = pn < 4 ? QSCALE : 1.0f; const int colb = (pn & 3) * 256 + wc * 32 + 8 * fq;
            const bool rot = ((wc & 1) == 0) && (fq < 2);
#pragma unroll
            for (int ai = 0; ai < 2; ++ai)
#pragma unroll
                for (int m = 0; m < 4; ++m) { const int row = row0 + ai * 128 + m * 16; f32x4 c4 = {1.f, 1.f, 1.f, 1.f}, s4 = {0.f, 0.f, 0.f, 0.f}; const float rsv = RS_AT(ai, m);
                    if (rot) { const int t = row & (SEQ - 1); c4 = *(const f32x4*)(cosT + t * 8 + 4 * fq); s4 = *(const f32x4*)(sinT + t * 8 + 4 * fq); }
#pragma unroll
                    for (int bj = 0; bj < 2; ++bj) { f32x4 x1 = acc[ai][bj][m][0] * rsv, x2 = acc[ai][bj][m][1] * rsv;
                        const f32x4 y1 = x1 * c4 - x2 * s4, y2 = x2 * c4 + x1 * s4;
                        if (rot) { x1 = y1; x2 = y2; }
                        st8(dst + (size_t)row * DM + colb + bj * 128, x1 * sc, x2 * sc); } EFENCE(); }
        } else if (pn < 16) {
            bf16_t* dst = pn < 12 ? V : CB; const int colb = (pn & 3) * 256 + wc * 32 + 8 * fq;
#pragma unroll
            for (int ai = 0; ai < 2; ++ai)
#pragma unroll
                for (int m = 0; m < 4; ++m) { const int row = row0 + ai * 128 + m * 16; const float rsv = RS_AT(ai, m);
#pragma unroll
                    for (int bj = 0; bj < 2; ++bj) st8(dst + (size_t)row * DM + colb + bj * 128, acc[ai][bj][m][0] * rsv, acc[ai][bj][m][1] * rsv); EFENCE(); }
        } else if (pn < 24) {
            const int colb = (pn - 16) * 128 + wc * 32 + 8 * fq;
#pragma unroll
            for (int ai = 0; ai < 2; ++ai)
#pragma unroll
                for (int m = 0; m < 4; ++m) { const int row = row0 + ai * 128 + m * 16; const float rsv = RS_AT(ai, m); const float r2 = rsv * rsv;
                    st8(U + (size_t)row * DM + colb, acc[ai][0][m][0] * acc[ai][1][m][0] * r2, acc[ai][0][m][1] * acc[ai][1][m][1] * r2); EFENCE(); }
        } else {
            const int colb = (pn - 24) * 256 + wc * 32 + 8 * fq;
#pragma unroll
            for (int ai = 0; ai < 2; ++ai)
#pragma unroll
                for (int m = 0; m < 4; ++m) { const int row = row0 + ai * 128 + m * 16; const float rsv = RS_AT(ai, m);
#pragma unroll
                    for (int bj = 0; bj < 2; ++bj) { f32x4 a = acc[ai][bj][m][0] * rsv, b = acc[ai][bj][m][1] * rsv;
#pragma unroll
                        for (int j = 0; j < 4; ++j) { a[j] = sigmoidf_(a[j]); b[j] = sigmoidf_(b[j]); }
                        st8(G + (size_t)row * 2048 + colb + bj * 128, a, b); } EFENCE(); }
        }
#undef RS_AT
        return false;
    }
};
struct EpiPlain {
    static constexpr bool PERM = true;
    bf16_t* O; int ldc; const float* part; float scale; size_t aux_stride;
    __device__ __forceinline__ bool operator()(f32x4 (&acc)[2][2][4][2], const pg8::Unit& u, int wr, int wc, int fr, int fq) const {
        const int row0 = u.pm * 256 + wr * 64 + fr, colb = u.pn * 256 + wc * 32 + 8 * fq; bf16_t* base = O + (size_t)u.aux * aux_stride;
#pragma unroll
        for (int ai = 0; ai < 2; ++ai)
#pragma unroll
            for (int m = 0; m < 4; ++m) { const int row = row0 + ai * 128 + m * 16; const float s = part ? row_rscale(part, row) * scale : scale;
#pragma unroll
                for (int bj = 0; bj < 2; ++bj) st8(base + (size_t)row * ldc + colb + bj * 128, acc[ai][bj][m][0] * s, acc[ai][bj][m][1] * s); }
        return false;
    }
};
struct EpiRes {
    static constexpr bool PERM = false;
    const float* xin; float* xout; bf16_t* xb; float* part;
    __device__ __forceinline__ bool operator()(f32x4 (&acc)[2][2][4][2], const pg8::Unit& u, int wr, int wc, int fr, int fq) const {
        const int row0 = u.pm * 256 + wr * 64 + fr, col0 = u.pn * 256 + wc * 32 + 4 * fq;
#pragma unroll
        for (int ai = 0; ai < 2; ++ai)
#pragma unroll
            for (int m = 0; m < 4; ++m) { const int row = row0 + ai * 128 + m * 16; float ss = 0.f;
#pragma unroll
                for (int bj = 0; bj < 2; ++bj)
#pragma unroll
                    for (int n = 0; n < 2; ++n) { const size_t off = (size_t)row * DM + col0 + bj * 128 + n * 16;
                        const f32x4 xv = *(const f32x4*)(xin + off) + acc[ai][bj][m][n]; *(f32x4*)(xout + off) = xv;
                        ss += (xv[0] * xv[0] + xv[1] * xv[1]) + (xv[2] * xv[2] + xv[3] * xv[3]);
                        u32x2 w; w.x = cvt_pk_bf16(xv[0], xv[1]); w.y = cvt_pk_bf16(xv[2], xv[3]); *(u32x2*)(xb + off) = w; }
                ss += swz_xor<16>(ss); ss = half_sum(ss);
                if (fq == 0) part[(size_t)row * 16 + u.pn * 4 + wc] = ss; }
        return false;
    }
};
struct EpiBr {
    static constexpr bool PERM = true;
    const bf16_t* G; bf16_t* Mo;
    __device__ __forceinline__ bool operator()(f32x4 (&acc)[2][2][4][2], const pg8::Unit& u, int wr, int wc, int fr, int fq) const {
        const int row0 = u.pm * 256 + wr * 64 + fr, colb = u.pn * 256 + wc * 32 + 8 * fq; const bool first = (u.aux == 0);
#pragma unroll
        for (int ai = 0; ai < 2; ++ai)
#pragma unroll
            for (int m = 0; m < 4; ++m) { const int row = row0 + ai * 128 + m * 16;
#pragma unroll
                for (int bj = 0; bj < 2; ++bj) { const u32x4 g0 = *(const u32x4*)(G + (size_t)row * 2048 + colb + bj * 128), g1 = *(const u32x4*)(G + (size_t)row * 2048 + 1024 + colb + bj * 128);
                    f32x4 a0 = {bf_lo(g0.x), bf_hi(g0.x), bf_lo(g0.y), bf_hi(g0.y)}, a1 = {bf_lo(g0.z), bf_hi(g0.z), bf_lo(g0.w), bf_hi(g0.w)};
                    f32x4 b0 = {bf_lo(g1.x), bf_hi(g1.x), bf_lo(g1.y), bf_hi(g1.y)}, b1 = {bf_lo(g1.z), bf_hi(g1.z), bf_lo(g1.w), bf_hi(g1.w)};
                    if (first) {
#pragma unroll
                        for (int j = 0; j < 4; ++j) { acc[ai][bj][m][0][j] *= a0[j] / b0[j]; acc[ai][bj][m][1][j] *= a1[j] / b1[j]; }
                    } else st8(Mo + (size_t)row * DM + colb + bj * 128, acc[ai][bj][m][0] * b0, acc[ai][bj][m][1] * b1); } }
        return first;
    }
};
struct EpiGU {
    static constexpr bool PERM = true;
    const float* part; bf16_t* ACT;
    __device__ __forceinline__ bool operator()(f32x4 (&acc)[2][2][4][2], const pg8::Unit& u, int wr, int wc, int fr, int fq) const {
        const int colb = u.pn * 128 + wc * 32 + 8 * fq;
#pragma unroll
        for (int ai = 0; ai < 2; ++ai)
#pragma unroll
            for (int m = 0; m < 4; ++m) { const int rl = ai * 128 + wr * 64 + m * 16 + fr; const int tok = (rl < u.nvalid) ? u.gidx[rl] : 0; const float s = row_rscale(part, tok);
                f32x4 o[2];
#pragma unroll
                for (int n = 0; n < 2; ++n) { const f32x4 g = acc[ai][0][m][n] * s, up = acc[ai][1][m][n] * s;
#pragma unroll
                    for (int j = 0; j < 4; ++j) o[n][j] = g[j] * sigmoidf_(g[j]) * up[j]; }
                st8(ACT + (size_t)(u.pm * 256 + rl) * DE + colb, o[0], o[1]); }
        return false;
    }
};

namespace att {
#define SBAR() __builtin_amdgcn_sched_barrier(0)
constexpr float THR2 = 11.541560327111707f;
__device__ __forceinline__ int crow(int r, int hi) { return (r & 3) + 8 * (r >> 2) + 4 * hi; }
template <int DQK> __device__ __forceinline__ int kswz(int row, int colB) {
    if constexpr (DQK == 64) return row * 128 + (colB ^ (((row >> 1) & 7) << 4));
    else return row * 512 + (colB ^ ((row & 15) << 4));
}
__device__ __forceinline__ void partialSM(f32x16& p0, f32x16& p1, float& m_reg, float& mn, float& alpha) {
    float pmax = p0[0];
#pragma unroll
    for (int r = 1; r < 16; ++r) pmax = fmaxf(pmax, p0[r]);
#pragma unroll
    for (int r = 0; r < 16; ++r) pmax = fmaxf(pmax, p1[r]);
    { auto rr = __builtin_amdgcn_permlane32_swap(__float_as_uint(pmax), __float_as_uint(pmax), false, false);
      pmax = fmaxf(__uint_as_float(rr[0]), __uint_as_float(rr[1])); }
    if (__builtin_expect(__all(pmax - m_reg <= THR2), 1)) { mn = m_reg; alpha = 1.f; }
    else { mn = fmaxf(m_reg, pmax); alpha = __builtin_amdgcn_exp2f(m_reg - mn); m_reg = mn; }
#pragma unroll
    for (int r = 0; r < 16; ++r) p0[r] = p0[r] - mn;
#pragma unroll
    for (int r = 0; r < 16; ++r) p1[r] = p1[r] - mn;
#pragma unroll
    for (int r = 0; r < 16; ++r) p0[r] = __builtin_amdgcn_exp2f(p0[r]);
}
__device__ __forceinline__ void finishSM(f32x16& p0, f32x16& p1, float alpha, float& l_reg, bf16x8& pa0, bf16x8& pa1, bf16x8& pa2, bf16x8& pa3) {
#pragma unroll
    for (int r = 0; r < 16; ++r) p1[r] = __builtin_amdgcn_exp2f(p1[r]);
    float ps = 0;
#pragma unroll
    for (int r = 0; r < 16; ++r) ps += p0[r];
#pragma unroll
    for (int r = 0; r < 16; ++r) ps += p1[r];
    { auto rr = __builtin_amdgcn_permlane32_swap(__float_as_uint(ps), __float_as_uint(ps), false, false);
      ps = __uint_as_float(rr[0]) + __uint_as_float(rr[1]); }
    l_reg = l_reg * alpha + ps;
#define PK4(P, BASE, OUT) do { unsigned a0 = cvt_pk_bf16(P[BASE + 0], P[BASE + 1]), a1 = cvt_pk_bf16(P[BASE + 2], P[BASE + 3]);   \
    unsigned b0 = cvt_pk_bf16(P[BASE + 4], P[BASE + 5]), b1 = cvt_pk_bf16(P[BASE + 6], P[BASE + 7]);                              \
    auto r0 = __builtin_amdgcn_permlane32_swap(a0, b0, false, false); auto r1 = __builtin_amdgcn_permlane32_swap(a1, b1, false, false); \
    u32x4 w = {r0[0], r1[0], r0[1], r1[1]}; OUT = *reinterpret_cast<bf16x8*>(&w); } while (0)
    PK4(p0, 0, pa0); PK4(p0, 8, pa1); PK4(p1, 0, pa2); PK4(p1, 8, pa3);
#undef PK4
}
template <int DQK> __device__ __forceinline__ void qkt(f32x16& p0, f32x16& p1, const char* Ks, const bf16x8* qr, int r32, int hi) {
    p0 = f32x16{}; p1 = f32x16{};
#pragma unroll
    for (int d0 = 0; d0 < DQK / 16; ++d0) { const int cb = (d0 * 16 + hi * 8) * 2;
        const bf16x8 b0 = *reinterpret_cast<const bf16x8*>(Ks + kswz<DQK>(r32, cb));
        const bf16x8 b1 = *reinterpret_cast<const bf16x8*>(Ks + kswz<DQK>(32 + r32, cb));
        p0 = __builtin_amdgcn_mfma_f32_32x32x16_bf16(b0, qr[d0], p0, 0, 0, 0);
        p1 = __builtin_amdgcn_mfma_f32_32x32x16_bf16(b1, qr[d0], p1, 0, 0, 0); }
}
__device__ __forceinline__ int v_st(int k, int c) { const int kk = (k & ~0xC) | ((k & 4) << 1) | ((k & 8) >> 1); return ((kk >> 3) * 4 + (c >> 5)) * 512 + ((kk & 7) * 32 + (c & 31)) * 2; }
__device__ __forceinline__ int v_rd_base(int lane) { return ((lane & 3) << 3) | (((lane >> 2) & 3) << 6) | (((lane >> 4) & 1) << 5) | (((lane >> 5) & 1) << 8); }
constexpr int v_rd_off(int d0, int ks, int half) { return d0 * 512 + ks * 4096 + half * 2048; }
template <int OFF> __device__ __forceinline__ s16x4 tr_read(int vb) {
    s16x4 r; asm volatile("ds_read_b64_tr_b16 %0, %1 offset:%2" : "=&v"(r) : "v"(vb), "i"(OFF) : "memory"); return r;
}
template <int D0> __device__ __forceinline__ void pv_one(f32x16& od, int vb, bf16x8 pa0, bf16x8 pa1, bf16x8 pa2, bf16x8 pa3) {
    const s16x4 l0 = tr_read<v_rd_off(D0, 0, 0)>(vb), h0 = tr_read<v_rd_off(D0, 0, 1)>(vb), l1 = tr_read<v_rd_off(D0, 1, 0)>(vb), h1 = tr_read<v_rd_off(D0, 1, 1)>(vb);
    const s16x4 l2 = tr_read<v_rd_off(D0, 2, 0)>(vb), h2 = tr_read<v_rd_off(D0, 2, 1)>(vb), l3 = tr_read<v_rd_off(D0, 3, 0)>(vb), h3 = tr_read<v_rd_off(D0, 3, 1)>(vb);
    asm volatile("s_waitcnt lgkmcnt(0)" ::: "memory"); SBAR();
#define PK(L, H) (bf16x8){L[0], L[1], L[2], L[3], H[0], H[1], H[2], H[3]}
    od = __builtin_amdgcn_mfma_f32_32x32x16_bf16(pa0, PK(l0, h0), od, 0, 0, 0);
    od = __builtin_amdgcn_mfma_f32_32x32x16_bf16(pa1, PK(l1, h1), od, 0, 0, 0);
    od = __builtin_amdgcn_mfma_f32_32x32x16_bf16(pa2, PK(l2, h2), od, 0, 0, 0);
    od = __builtin_amdgcn_mfma_f32_32x32x16_bf16(pa3, PK(l3, h3), od, 0, 0, 0);
#undef PK
}
__device__ __forceinline__ void pv_d0(f32x16* o, int vb, bf16x8 pa0, bf16x8 pa1, bf16x8 pa2, bf16x8 pa3) {
    pv_one<0>(o[0], vb, pa0, pa1, pa2, pa3); pv_one<1>(o[1], vb, pa0, pa1, pa2, pa3); pv_one<2>(o[2], vb, pa0, pa1, pa2, pa3); pv_one<3>(o[3], vb, pa0, pa1, pa2, pa3);
}

constexpr int SHM_V = 16384, SHM_K64 = 8192, DA_LDS = 2 * SHM_V + 2 * SHM_K64 + 8 * 256;
__device__ __forceinline__ void diff_pass(const bf16_t* __restrict__ Qb, const bf16_t* __restrict__ Kh, const bf16_t* __restrict__ Vh, int seq, char* lds, f32x16 (&o)[4]) {
    int tid_ = threadIdx.x; asm volatile("" : "+v"(tid_));
    const int tid = tid_, wid = tid >> 6, lane = tid & 63, r32 = lane & 31, hi = lane >> 5;
    char* V_lds = lds; char* K_lds = lds + 2 * SHM_V;
    float* ws = (float*)(lds + 2 * SHM_V + 2 * SHM_K64) + wid * 64; float* li_l = ws; float* al_l = ws + 32;
    float m_reg = -1e30f, l_reg = 0;
#pragma unroll
    for (int d = 0; d < 4; ++d) o[d] = f32x16{};
    bf16x8 qr[4];
    const bf16_t* Qw = Qb + (size_t)(wid * 32 + r32) * DM + hi * 8;
#pragma unroll
    for (int d0 = 0; d0 < 4; ++d0) qr[d0] = *reinterpret_cast<const bf16x8*>(Qw + d0 * 16);
    const int sr = tid >> 4, sc = (tid & 15) * 8, vst0 = v_st(sr, sc), vst1 = v_st(32 + sr, sc);
    const int kr = tid >> 3, kc = (tid & 7) * 8, kst = kswz<64>(kr, kc * 2);
    const int vb0 = (int)(uintptr_t)V_lds + v_rd_base(lane);
    struct { bf16x8 vs0, vs1, ks; } sr_[2];
#define SLOAD(i, k0) do { sr_[i].vs0 = *reinterpret_cast<const bf16x8*>(&Vh[(size_t)((k0) + sr) * DM + sc]); sr_[i].vs1 = *reinterpret_cast<const bf16x8*>(&Vh[(size_t)((k0) + 32 + sr) * DM + sc]); \
    sr_[i].ks = *reinterpret_cast<const bf16x8*>(&Kh[(size_t)((k0) + kr) * DM + kc]); } while (0)
#define SWRITE(b, i) do { *(bf16x8*)(V_lds + (b) * SHM_V + vst0) = sr_[i].vs0; *(bf16x8*)(V_lds + (b) * SHM_V + vst1) = sr_[i].vs1; \
    *(bf16x8*)(K_lds + (b) * SHM_K64 + kst) = sr_[i].ks; } while (0)
#define SWAIT() asm volatile("s_waitcnt vmcnt(3)" ::: "memory")
#define RESC(a) do { if (__any((a) < 1.f)) { if (hi == 0) al_l[r32] = (a); asm volatile("s_waitcnt lgkmcnt(0)" ::: "memory"); \
    _Pragma("unroll") for (int d = 0; d < 4; ++d) _Pragma("unroll") for (int r = 0; r < 16; ++r) o[d][r] *= al_l[crow(r, hi)]; } } while (0)
    f32x16 pA0, pA1, pB0, pB1; float mnA, mnB, alA, alB; bf16x8 pa0, pa1, pa2, pa3; const int NT = seq / 64;
    __syncthreads();
    SLOAD(0, 0); asm volatile("s_waitcnt vmcnt(0)" ::: "memory"); SWRITE(0, 0); __syncthreads();
    qkt<64>(pA0, pA1, K_lds, qr, r32, hi); partialSM(pA0, pA1, m_reg, mnA, alA);
    SLOAD(1, 64); if (2 < NT) SLOAD(0, 128);
    SWAIT(); SWRITE(1, 1); __syncthreads();
    for (int j = 1; j + 1 < NT; j += 2) {
        SBAR(); qkt<64>(pB0, pB1, K_lds + SHM_K64, qr, r32, hi);
        finishSM(pA0, pA1, alA, l_reg, pa0, pa1, pa2, pa3); SBAR();
        SLOAD(1, (j + 2) * 64); SBAR();
        pv_d0(o, vb0, pa0, pa1, pa2, pa3); partialSM(pB0, pB1, m_reg, mnB, alB);
        __syncthreads(); SWAIT(); SWRITE(0, 0);
        RESC(alB); __syncthreads();
        SBAR(); qkt<64>(pA0, pA1, K_lds, qr, r32, hi);
        finishSM(pB0, pB1, alB, l_reg, pa0, pa1, pa2, pa3); SBAR();
        if (j + 3 < NT) SLOAD(0, (j + 3) * 64); SBAR();
        pv_d0(o, vb0 + SHM_V, pa0, pa1, pa2, pa3); partialSM(pA0, pA1, m_reg, mnA, alA);
        __syncthreads(); SWAIT(); SWRITE(1, 1);
        RESC(alA); __syncthreads();
    }
    SBAR(); qkt<64>(pB0, pB1, K_lds + SHM_K64, qr, r32, hi);
    finishSM(pA0, pA1, alA, l_reg, pa0, pa1, pa2, pa3); SBAR();
    pv_d0(o, vb0, pa0, pa1, pa2, pa3); partialSM(pB0, pB1, m_reg, mnB, alB);
    __syncthreads(); RESC(alB);
    finishSM(pB0, pB1, alB, l_reg, pa0, pa1, pa2, pa3); SBAR();
    pv_d0(o, vb0 + SHM_V, pa0, pa1, pa2, pa3);
    if (hi == 0) li_l[r32] = l_reg; asm volatile("s_waitcnt lgkmcnt(0)" ::: "memory");
#pragma unroll
    for (int r = 0; r < 16; ++r) { const float rl = __builtin_amdgcn_rcpf(li_l[crow(r, hi)]);
#pragma unroll
        for (int d = 0; d < 4; ++d) o[d][r] *= rl; }
#undef SLOAD
#undef SWRITE
#undef SWAIT
#undef RESC
}

__device__ __forceinline__ void diff_unit(int b, int h, int qb, const bf16_t* Q, const bf16_t* K, const bf16_t* V, bf16_t* YA, float lam, float omli, const float* subln, char* lds) {
    int tid_ = threadIdx.x; asm volatile("" : "+v"(tid_));
    const int tid = tid_, wid = tid >> 6, lane = tid & 63, r32 = lane & 31, hi = lane >> 5;
    const size_t rowbase = (size_t)b * SEQ; const int q0 = qb * 256;
    const bf16_t* Qb = Q + (rowbase + q0) * DM + h * 128;
    const bf16_t* Kh = K + rowbase * DM + h * 128;
    const bf16_t* Vh = V + rowbase * DM + h * 128;
    f32x16 o[4];
    diff_pass(Qb, Kh, Vh, SEQ, lds, o);
    unsigned* park = (unsigned*)(lds + DA_LDS) + wid * 2048 + lane;
#pragma unroll
    for (int d = 0; d < 4; ++d)
#pragma unroll
        for (int r = 0; r < 8; ++r) park[(d * 8 + r) * 64] = cvt_pk_bf16(o[d][2 * r], o[d][2 * r + 1]);
    diff_pass(Qb + 64, Kh + 64, Vh, SEQ, lds, o);
    asm volatile("s_waitcnt lgkmcnt(0)" ::: "memory");
    float ss[16];
#pragma unroll
    for (int r = 0; r < 16; ++r) { float s = 0.f;
#pragma unroll
        for (int d = 0; d < 4; ++d) { const unsigned pw = park[(d * 8 + (r >> 1)) * 64]; const float a = (r & 1) ? bf_hi(pw) : bf_lo(pw); const float v = a - lam * o[d][r]; o[d][r] = v; s += v * v; }
        ss[r] = s; }
#pragma unroll
    for (int r = 0; r < 16; ++r) {
        ss[r] = sum32(ss[r]);
        ss[r] = omli / sqrtf(ss[r] * (1.0f / 128.0f) + EPS); }
    float gl[4];
#pragma unroll
    for (int d = 0; d < 4; ++d) gl[d] = subln[32 * d + r32];
    bf16_t* Ow = YA + (rowbase + q0 + wid * 32) * DM + h * 128 + r32;
#pragma unroll
    for (int r = 0; r < 16; ++r) { const int orow = crow(r, hi);
#pragma unroll
        for (int d = 0; d < 4; ++d) Ow[(size_t)orow * DM + 32 * d] = (bf16_t)(cvt_pk_bf16(o[d][r] * ss[r] * gl[d], 0.f) & 0xffffu); }
}

constexpr int CA_LDS = 32768 + 32768 + 8 * 256;
__device__ __forceinline__ void cross_unit(int b, int hd, int qb, const bf16_t* QC, const bf16_t* KV, bf16_t* OC, char* lds) {
    int tid_ = threadIdx.x; asm volatile("" : "+v"(tid_));
    const int tid = tid_, wid = tid >> 6, lane = tid & 63, r32 = lane & 31, hi = lane >> 5, vimg = wid >> 2;
    char* K_lds = lds; char* V_lds = lds + 32768; float* ws = (float*)(lds + 65536) + wid * 64; float* li_l = ws; float* al_l = ws + 32;
    const size_t qrow = (size_t)b * SEQ + qb * 128 + (wid & 3) * 32;
    const bf16_t* Qw = QC + (qrow + r32) * DM + hd * 256 + hi * 8;
    bf16x8 qr[16];
#pragma unroll
    for (int d0 = 0; d0 < 16; ++d0) qr[d0] = *reinterpret_cast<const bf16x8*>(Qw + d0 * 16);
    const bf16_t* Kh = KV + (size_t)(b * NMEM) * 2048 + hd * 256; const bf16_t* Vh = Kh + 1024;
    const int kr = tid >> 3, kc8 = tid & 7, sr = tid >> 4, sc = (tid & 15) * 8, vst0 = v_st(sr, sc), vst1 = v_st(32 + sr, sc);
    const int vb0 = (int)(uintptr_t)V_lds + vimg * SHM_V + v_rd_base(lane);
    float m_reg = -1e30f, l_reg = 0; f32x16 o[4];
#pragma unroll
    for (int d = 0; d < 4; ++d) o[d] = f32x16{};
    for (int t = 0; t < 4; ++t) {
        const int k0 = t * 64;
        __syncthreads();
        { bf16x8 kk[4];
#pragma unroll
          for (int j = 0; j < 4; ++j) kk[j] = *reinterpret_cast<const bf16x8*>(&Kh[(size_t)(k0 + kr) * 2048 + (kc8 + 8 * j) * 8]);
#pragma unroll
          for (int j = 0; j < 4; ++j) *(bf16x8*)(K_lds + kswz<256>(kr, (kc8 + 8 * j) * 16)) = kk[j]; }
        asm volatile("" ::: "memory");
        { bf16x8 vv[4];
          vv[0] = *reinterpret_cast<const bf16x8*>(&Vh[(size_t)(k0 + sr) * 2048 + sc]);       vv[1] = *reinterpret_cast<const bf16x8*>(&Vh[(size_t)(k0 + 32 + sr) * 2048 + sc]);
          vv[2] = *reinterpret_cast<const bf16x8*>(&Vh[(size_t)(k0 + sr) * 2048 + 128 + sc]); vv[3] = *reinterpret_cast<const bf16x8*>(&Vh[(size_t)(k0 + 32 + sr) * 2048 + 128 + sc]);
          *(bf16x8*)(V_lds + vst0) = vv[0]; *(bf16x8*)(V_lds + vst1) = vv[1]; *(bf16x8*)(V_lds + SHM_V + vst0) = vv[2]; *(bf16x8*)(V_lds + SHM_V + vst1) = vv[3]; }
        __syncthreads();
        f32x16 p0, p1; float mn, al; bf16x8 pa0, pa1, pa2, pa3;
        qkt<256>(p0, p1, K_lds, qr, r32, hi); partialSM(p0, p1, m_reg, mn, al);
        if (__any(al < 1.f)) { if (hi == 0) al_l[r32] = al; asm volatile("s_waitcnt lgkmcnt(0)" ::: "memory");
#pragma unroll
            for (int d = 0; d < 4; ++d)
#pragma unroll
                for (int r = 0; r < 16; ++r) o[d][r] *= al_l[crow(r, hi)]; }
        finishSM(p0, p1, al, l_reg, pa0, pa1, pa2, pa3); SBAR();
        pv_d0(o, vb0, pa0, pa1, pa2, pa3);
    }
    if (hi == 0) li_l[r32] = l_reg; asm volatile("s_waitcnt lgkmcnt(0)" ::: "memory");
    bf16_t* Ow = OC + qrow * DM + hd * 256 + vimg * 128 + r32;
#pragma unroll
    for (int r = 0; r < 16; ++r) { const float rl = __builtin_amdgcn_rcpf(li_l[crow(r, hi)]); const int orow = crow(r, hi);
#pragma unroll
        for (int d = 0; d < 4; ++d) Ow[(size_t)orow * DM + 32 * d] = (bf16_t)(cvt_pk_bf16(o[d][r] * rl, 0.f) & 0xffffu); }
    __syncthreads();
}
#undef SBAR
}

__device__ __forceinline__ f32x4 ld_bf4(const bf16_t* p) { const u32x2 w = *(const u32x2*)p; return (f32x4){bf_lo(w.x), bf_hi(w.x), bf_lo(w.y), bf_hi(w.y)}; }
__device__ __forceinline__ void st_bf4(bf16_t* p, f32x4 v) { u32x2 w; w.x = cvt_pk_bf16(v[0], v[1]); w.y = cvt_pk_bf16(v[2], v[3]); *(u32x2*)p = w; }
__device__ __forceinline__ void ld_bf8(const bf16_t* p, f32x4& a, f32x4& b) { const u32x4 w = *(const u32x4*)p; a = (f32x4){bf_lo(w.x), bf_hi(w.x), bf_lo(w.y), bf_hi(w.y)}; b = (f32x4){bf_lo(w.z), bf_hi(w.z), bf_lo(w.w), bf_hi(w.w)}; }

__device__ __forceinline__ void conv_rows(const bf16_t* U, const bf16_t* CB, const float* cw, bf16_t* YC, int gw, int NGW, int lane) {
    for (int g = gw; g < T / 8; g += NGW) { const int t0 = g * 8;
#pragma unroll
        for (int c2 = 0; c2 < 2; ++c2) { const int col = c2 * 512 + lane * 8;
            f32x4 w0a = *(const f32x4*)(cw + col), w0b = *(const f32x4*)(cw + col + 4), w1a = *(const f32x4*)(cw + DM + col), w1b = *(const f32x4*)(cw + DM + col + 4),
                  w2a = *(const f32x4*)(cw + 2 * DM + col), w2b = *(const f32x4*)(cw + 2 * DM + col + 4);
            f32x4 pa = {0.f, 0.f, 0.f, 0.f}, pb = pa, ca, cb_, na, nb;
            if ((t0 & (SEQ - 1)) != 0) ld_bf8(U + (size_t)(t0 - 1) * DM + col, pa, pb);
            ld_bf8(U + (size_t)t0 * DM + col, ca, cb_);
            for (int i = 0; i < 8; ++i) { const int t = t0 + i;
                if (((t + 1) & (SEQ - 1)) != 0) ld_bf8(U + (size_t)(t + 1) * DM + col, na, nb); else { na = (f32x4){0.f, 0.f, 0.f, 0.f}; nb = na; }
                f32x4 ga, gb; ld_bf8(CB + (size_t)t * DM + col, ga, gb);
                st8(YC + (size_t)t * DM + col, ga * (w0a * pa + w1a * ca + w2a * na), gb * (w0b * pb + w1b * cb_ + w2b * nb));
                pa = ca; pb = cb_; ca = na; cb_ = nb; } } }
}
__device__ __forceinline__ void x0_row(const float* xrow, bf16_t* xbrow, float* prow, int lane) {
    const f32x4* xr = (const f32x4*)xrow + lane; float s = 0.f;
#pragma unroll
    for (int j = 0; j < 4; ++j) { const f32x4 v = xr[64 * j]; s += (v[0] * v[0] + v[1] * v[1]) + (v[2] * v[2] + v[3] * v[3]); st_bf4(xbrow + j * 256 + lane * 4, v); }
    s = wave_sum(s);
    if (lane < 16) prow[lane] = lane == 0 ? s : 0.f;
}
__device__ __forceinline__ void memn_row(const float* xrow, const float* g, bf16_t* orow, int lane) {
    const f32x4* xr = (const f32x4*)xrow + lane; const f32x4* gr = (const f32x4*)g + lane; f32x4 v[4]; float s = 0.f;
#pragma unroll
    for (int j = 0; j < 4; ++j) { v[j] = xr[64 * j]; s += (v[j][0] * v[j][0] + v[j][1] * v[j][1]) + (v[j][2] * v[j][2] + v[j][3] * v[j][3]); }
    const float r = 1.0f / sqrtf(wave_sum(s) * (1.0f / DM) + EPS);
#pragma unroll
    for (int j = 0; j < 4; ++j) st_bf4(orow + j * 256 + lane * 4, v[j] * r * gr[64 * j]);
}
__device__ __forceinline__ void combine_row(int t, const LAS int* bst, const int* tok_e, const int* tok_pos, const float* tok_w, const bf16_t* Y, float* xio, bf16_t* xb, float* part, const float* gfin, bool last, int lane) {
    const int e0 = tok_e[2 * t], e1 = tok_e[2 * t + 1]; const float w0 = tok_w[2 * t], w1 = tok_w[2 * t + 1];
    const size_t s0 = (size_t)bst[e0] * 256 + tok_pos[2 * t], s1 = (size_t)bst[e1] * 256 + tok_pos[2 * t + 1];
    f32x4 v[4]; float s = 0.f;
#pragma unroll
    for (int j = 0; j < 4; ++j) { const int c = j * 256 + lane * 4;
        v[j] = *(const f32x4*)(xio + (size_t)t * DM + c) + w0 * ld_bf4(Y + s0 * DM + c) + w1 * ld_bf4(Y + s1 * DM + c);
        s += (v[j][0] * v[j][0] + v[j][1] * v[j][1]) + (v[j][2] * v[j][2] + v[j][3] * v[j][3]); }
    s = wave_sum(s);
    if (!last) {
#pragma unroll
        for (int j = 0; j < 4; ++j) { const int c = j * 256 + lane * 4; *(f32x4*)(xio + (size_t)t * DM + c) = v[j]; st_bf4(xb + (size_t)t * DM + c, v[j]); }
        if (lane < 16) part[(size_t)t * 16 + lane] = lane == 0 ? s : 0.f;
    } else {
        const float r = 1.0f / sqrtf(s * (1.0f / DM) + EPS);
#pragma unroll
        for (int j = 0; j < 4; ++j) { const int c = j * 256 + lane * 4; *(f32x4*)(xio + (size_t)t * DM + c) = v[j] * r * *(const f32x4*)(gfin + c); }
    }
}
__device__ __forceinline__ void route_token(int t, const float* x, const float* part, const float (&gf)[16], const f32x4 (&wg)[16], const LAS char* WeL,
                                            unsigned* ecnt, int* elist, int* tok_e, int* tok_pos, float* tok_w, int lane) {
    float pp = lane < 16 ? part[(size_t)t * 16 + lane] : 0.f; pp = wave_sum(pp);
    const float rs = 1.0f / sqrtf(pp * (1.0f / DM) + EPS);
    float hv[16]; f32x4 ag = {0.f, 0.f, 0.f, 0.f};
#pragma unroll
    for (int j = 0; j < 16; ++j) { hv[j] = x[(size_t)t * DM + j * 64 + lane] * rs * gf[j]; ag += hv[j] * wg[j]; }
    float a0 = wave_sum(ag[0]), a1 = wave_sum(ag[1]), a2 = wave_sum(ag[2]), a3 = wave_sum(ag[3]);
    int gi = 0; float am = a0; if (a1 > am) { am = a1; gi = 1; } if (a2 > am) { am = a2; gi = 2; } if (a3 > am) { am = a3; gi = 3; }
    const float gw_ = 1.0f / (__expf(a0 - am) + __expf(a1 - am) + __expf(a2 - am) + __expf(a3 - am));
    gi = __builtin_amdgcn_readfirstlane(gi);
    f32x4 ea = {0.f, 0.f, 0.f, 0.f}, eb = ea;
#pragma unroll
    for (int j = 0; j < 16; ++j) { const int k = j * 64 + lane; const int sw = (k >> 1) & 7;
        const f32x4 wa = *(const LAS f32x4*)(WeL + k * 128 + (((2 * gi) ^ sw) << 4)), wb = *(const LAS f32x4*)(WeL + k * 128 + (((2 * gi + 1) ^ sw) << 4));
        ea += hv[j] * wa; eb += hv[j] * wb; }
    float e[8];
#pragma unroll
    for (int q = 0; q < 4; ++q) { e[q] = wave_sum(ea[q]); e[4 + q] = wave_sum(eb[q]); }
    int i1 = 0; float e1v = e[0];
#pragma unroll
    for (int q = 1; q < 8; ++q) if (e[q] > e1v) { e1v = e[q]; i1 = q; }
    int i2 = (i1 == 0) ? 1 : 0; float e2v = -3.0e38f;
#pragma unroll
    for (int q = 0; q < 8; ++q) if (q != i1 && e[q] > e2v) { e2v = e[q]; i2 = q; }
    const float z = __expf(e2v - e1v); const float w1 = gw_ / (1.0f + z), w2 = gw_ * z / (1.0f + z);
    if (lane == 0) {
        const int x1 = gi * 8 + i1, x2 = gi * 8 + i2;
        const int p1 = (int)atomicAdd(ecnt + x1 * 64, 1u), p2 = (int)atomicAdd(ecnt + x2 * 64, 1u);
        elist[(size_t)x1 * T + p1] = t; elist[(size_t)x2 * T + p2] = t;
        tok_e[2 * t] = x1; tok_e[2 * t + 1] = x2; tok_pos[2 * t] = p1; tok_pos[2 * t + 1] = p2; tok_w[2 * t] = w1; tok_w[2 * t + 1] = w2;
    }
}

__device__ __forceinline__ int map_row(int mode, int n) {
    if (mode == 1) {
        if (n < 2048) { const int d = n & 63; const int p = (d >= 4 && d < 8) ? d + 4 : (d >= 8 && d < 12) ? d - 4 : d; return (n & ~63) + p; }
        if (n >= 4096 && n < 5120) { const int q = n - 4096; return 4096 + (q >> 7) * 256 + (q & 127); }
        if (n >= 5120 && n < 6144) { const int q = n - 5120; return 4096 + (q >> 7) * 256 + 128 + (q & 127); }
        return n;
    }
    if (mode == 2) return (n >> 7) * 256 + (n & 127);
    if (mode == 3) return (n >> 7) * 256 + 128 + (n & 127);
    return n;
}
__device__ __forceinline__ void transpose_item(const float* W, int ldw, int k0, int n0, const float* gain, bf16_t* WT, int ldt, int mode, LAS float* scr, int lane) {
    f32x4 v[16];
#pragma unroll
    for (int i = 0; i < 16; ++i) v[i] = *(const f32x4*)(W + (size_t)(k0 + 4 * i + (lane >> 4)) * ldw + n0 + (lane & 15) * 4);
    if (gain) {
#pragma unroll
        for (int i = 0; i < 16; ++i) v[i] = v[i] * gain[k0 + 4 * i + (lane >> 4)];
    }
#pragma unroll
    for (int i = 0; i < 16; ++i) { LAS float* s = scr + (4 * i + (lane >> 4)) * 65 + (lane & 15) * 4; s[0] = v[i][0]; s[1] = v[i][1]; s[2] = v[i][2]; s[3] = v[i][3]; }
    LDS_WAIT(); asm volatile("" ::: "memory");
    const int c = lane & 7;
#pragma unroll
    for (int j = 0; j < 8; ++j) { const int n = (lane >> 3) + 8 * j; const LAS float* s = scr + (8 * c) * 65 + n;
        u32x4 o; o.x = cvt_pk_bf16(s[0 * 65], s[1 * 65]); o.y = cvt_pk_bf16(s[2 * 65], s[3 * 65]); o.z = cvt_pk_bf16(s[4 * 65], s[5 * 65]); o.w = cvt_pk_bf16(s[6 * 65], s[7 * 65]);
        *(u32x4*)(WT + (size_t)map_row(mode, n0 + n) * ldt + k0 + 8 * c) = o; }
    LDS_WAIT(); asm volatile("" ::: "memory");
}
constexpr int IT_IN = 2048, IT_BR = 512, IT_SQ = 256, IT_KV = 512, IT_EXP = 576, IT_LAYER = IT_IN + IT_BR + 3 * IT_SQ + IT_KV + 32 * IT_EXP;
__device__ __forceinline__ void rope_entry(int idx, float* cosT, float* sinT) {
    const int t = idx >> 3, i = idx & 7;
    const double inv = i == 0 ? 1.0 : i == 1 ? 0.19392274474868576 : i == 2 ? 0.03760603093086393 : i == 3 ? 0.007292664737217109 : i == 4 ? 0.001414213562373095 : i == 5 ? 0.0002742481756762073 : i == 6 ? 5.318295896944988e-05 : 1.031338537721246e-05;
    const double ang = (double)t * inv;
    const double kq = __builtin_rint(ang * 0.6366197723675814);
    const double r = (ang - kq * 1.5707963267341256) - kq * 6.077100506506192e-11;
    const double r2 = r * r;
    double sn = 1.0 / 6227020800.0; sn = sn * r2 - 1.0 / 39916800.0; sn = sn * r2 + 1.0 / 362880.0; sn = sn * r2 - 1.0 / 5040.0; sn = sn * r2 + 1.0 / 120.0; sn = sn * r2 - 1.0 / 6.0; sn = sn * r2 + 1.0; sn = sn * r;
    double cs = 1.0 / 479001600.0; cs = cs * r2 - 1.0 / 3628800.0; cs = cs * r2 + 1.0 / 40320.0; cs = cs * r2 - 1.0 / 720.0; cs = cs * r2 + 1.0 / 24.0; cs = cs * r2 - 0.5; cs = cs * r2 + 1.0;
    const int q = ((int)kq) & 3;
    const double c = q == 0 ? cs : q == 1 ? -sn : q == 2 ? -cs : sn;
    const double s = q == 0 ? sn : q == 1 ? cs : q == 2 ? -sn : -cs;
    cosT[idx] = (float)c; sinT[idx] = (float)s;
}

#define XB_TMO      128
#define XB_XCNT(j)  (256  + 64 * (j))
#define XB_XSUB(j)  (1280 + 64 * (j))
#define XB_XGEN(j)  (2304 + 64 * (j))
#define XB_TOP      3328
#define XB_TOPGEN   3392
#define XCD_BAR_WORDS 3456
#define XB_SPIN_CAP (1u << 18)
__device__ __forceinline__ unsigned xb_ld(unsigned* p)              { return __hip_atomic_load(p, __ATOMIC_RELAXED, __HIP_MEMORY_SCOPE_AGENT); }
__device__ __forceinline__ unsigned xb_add(unsigned* p, unsigned v) { return __hip_atomic_fetch_add(p, v, __ATOMIC_RELAXED, __HIP_MEMORY_SCOPE_AGENT); }
__device__ __forceinline__ unsigned xb_xcc_id() { return (unsigned)__builtin_amdgcn_s_getreg((3 << 11) | 20) & 0xFu; }
#define XB_SPIN(cond, bar) do { unsigned _sp = 0; while (cond) { __builtin_amdgcn_s_sleep(1); \
    if ((++_sp & 255u) == 0u) { if (xb_ld(&(bar)[XB_TMO])) break; if (_sp > XB_SPIN_CAP) { atomicAdd(&(bar)[XB_TMO], 1u); break; } } } } while (0)
struct XcdBarrier { unsigned* bar; unsigned x; volatile LAS unsigned* st; };
__device__ __forceinline__ XcdBarrier xcd_barrier_post(unsigned* bar, volatile LAS unsigned* st) {
    XcdBarrier b; b.bar = bar; b.x = (unsigned)__builtin_amdgcn_readfirstlane((int)xb_xcc_id()); b.st = st;
    if (threadIdx.x == 0) (void)xb_add(&bar[XB_XCNT(b.x)], 1u);
    return b;
}
__device__ __forceinline__ void xcd_barrier_complete(unsigned* bar, unsigned x, unsigned& nloc, unsigned& nx) {
    const unsigned G = gridDim.x * gridDim.y * gridDim.z;
    unsigned sum, cnt, mine, sp = 0u;
    for (;;) {
        sum = 0u; cnt = 0u; mine = 0u;
#pragma unroll
        for (unsigned j = 0; j < 16; ++j) { const unsigned c = xb_ld(&bar[XB_XCNT(j)]); sum += c; cnt += (c > 0u) ? 1u : 0u; mine = (j == x) ? c : mine; }
        if (sum == G) break;
        __builtin_amdgcn_s_sleep(1);
        if ((++sp & 255u) == 0u) { if (xb_ld(&bar[XB_TMO])) break; if (sp > XB_SPIN_CAP) { atomicAdd(&bar[XB_TMO], 1u); break; } }
    }
    nloc = mine > 0u ? mine : 1u; nx = cnt > 0u ? cnt : 1u;
}
__device__ __forceinline__ void xcd_barrier(const XcdBarrier& b) {
    asm volatile("s_waitcnt vmcnt(0)" ::: "memory");
    __syncthreads();
    int t0_ = threadIdx.x; asm volatile("" : "+v"(t0_));
    if (t0_ == 0) {
        unsigned* bar = b.bar; unsigned bx_ = b.x;
        asm volatile("" : "+s"(bar), "+s"(bx_));
        __builtin_amdgcn_s_waitcnt(0);
        unsigned nloc = b.st[0], nx = b.st[1];
        if (nloc == 0u) { xcd_barrier_complete(bar, bx_, nloc, nx); b.st[0] = nloc; b.st[1] = nx; }
        const unsigned old = xb_add(&bar[XB_XSUB(bx_)], 1u);
        const unsigned gen = old / nloc;
        if (old + 1u == (gen + 1u) * nloc) {
            __builtin_amdgcn_fence(__ATOMIC_RELEASE, "agent");
            asm volatile("s_waitcnt vmcnt(0)" ::: "memory");
            const unsigned og = xb_add(&bar[XB_TOP], 1u);
            const unsigned tg = og / nx;
            if (og + 1u == (tg + 1u) * nx) xb_add(&bar[XB_TOPGEN], 1u);
            else XB_SPIN(xb_ld(&bar[XB_TOPGEN]) == tg, bar);
            __builtin_amdgcn_fence(__ATOMIC_ACQUIRE, "agent");
            xb_add(&bar[XB_XGEN(bx_)], 1u);
            asm volatile("s_waitcnt vmcnt(0)" ::: "memory");
        } else {
            XB_SPIN(xb_ld(&bar[XB_XGEN(bx_)]) == gen, bar);
            __builtin_amdgcn_fence(__ATOMIC_ACQUIRE, "agent");
            asm volatile("s_waitcnt vmcnt(0)" ::: "memory");
        }
    }
    __syncthreads();
}

struct Args { const float* in[24]; float* out; unsigned char* ws; int ph_lo, ph_hi; };
enum { I_X = 0, I_MEM, I_NMIX, I_WIN, I_LQ1, I_LK1, I_LQ2, I_LK2, I_SUBLN, I_CONVW, I_WBR, I_WO, I_NCROSS, I_NMEM, I_WCQ, I_WCKV, I_WCO, I_NFFN, I_WRG, I_WRE, I_WG, I_WU, I_WD, I_NFIN };

__global__ void __launch_bounds__(512, 2) fwd(Args args) {
    extern __shared__ __attribute__((aligned(16))) unsigned char lds_raw[];
    LAS unsigned char* lds = (LAS unsigned char*)lds_raw;
    const int tid = threadIdx.x, lane = tid & 63, wave = __builtin_amdgcn_readfirstlane(tid >> 6);
    const int G = gridDim.x, bx = blockIdx.x, vcu = (G % 8 == 0) ? (bx % 8) * (G / 8) + bx / 8 : bx;
    const int gw0 = vcu * 8 + wave, NGW = G * 8;
    unsigned char* ws = args.ws;
    unsigned* ctl = (unsigned*)(ws + WS_CTL);
    for (int u = tid; u < (LDS_BYTES - LDSCTL_OFF) / 4; u += 512) ((LAS unsigned*)(lds + LDSCTL_OFF))[u] = 0u;
    __syncthreads();
    volatile LAS unsigned* MISC = (volatile LAS unsigned*)(lds + LC_MISC);
    LAS int* bst = (LAS int*)(lds + LC_BST); LAS int* cntL = (LAS int*)(lds + LC_CNT); LAS int* bexp = (LAS int*)(lds + LC_BEXP);
#if MK_SPLIT
    XcdBarrier bar; bar.bar = ctl + CW_BAR; bar.x = 0; bar.st = nullptr;
#define GRID_BAR() do { } while (0)
#else
    XcdBarrier bar = xcd_barrier_post(ctl + CW_BAR, MISC + 8);
#define GRID_BAR() xcd_barrier(bar)
#endif
    const int lo = args.ph_lo, hi_ = args.ph_hi; (void)lo; (void)hi_;
#ifndef PH_MASK
#define PH_MASK 0xfff
#endif
#define PEN(j) (((PH_MASK) >> (j)) & 1)
#if MK_SPLIT
#define IN(k) (lo <= (k) && (k) < hi_)
#else
#define IN(k) true
#endif
#define OPQ_LANE() int tid_o_ = threadIdx.x, gw_o_ = gw0; asm volatile("" : "+v"(tid_o_), "+s"(gw_o_)); const int tid = tid_o_, lane = tid_o_ & 63, gw = gw_o_; (void)tid; (void)lane; (void)gw
#define SEAM(k) do { if (IN(k) && IN((k) + 1)) GRID_BAR(); } while (0)
    float* cosT = (float*)(ws + WS_ROPE); float* sinT = cosT + SEQ * 8;
    float* part = (float*)(ws + WS_PART);
    int* tok_e = (int*)(ws + WS_TOK); int* tok_pos = tok_e + 2 * T; float* tok_w = (float*)(tok_pos + 2 * T);
    int* elist = (int*)(ws + WS_ELIST);
    bf16_t* memn = (bf16_t*)(ws + WS_MEMN); bf16_t* KVC = (bf16_t*)(ws + WS_KVC); bf16_t* XB = (bf16_t*)(ws + WS_XB);
    bf16_t* Qb = (bf16_t*)(ws + WS_Q); bf16_t* Kb = (bf16_t*)(ws + WS_K); bf16_t* Vb = (bf16_t*)(ws + WS_V); bf16_t* Ub = (bf16_t*)(ws + WS_U); bf16_t* CBb = (bf16_t*)(ws + WS_CB);
    bf16_t* Gb = (bf16_t*)(ws + WS_G); bf16_t* YA = (bf16_t*)(ws + WS_YA); bf16_t* YC = (bf16_t*)(ws + WS_YC); bf16_t* Mb = (bf16_t*)(ws + WS_M);
    bf16_t* QC = (bf16_t*)(ws + WS_QC); bf16_t* OC = (bf16_t*)(ws + WS_OC); bf16_t* ACT = (bf16_t*)(ws + WS_ACT); bf16_t* Yb = (bf16_t*)(ws + WS_Y);
    float* xs = args.out;

    if (IN(0) && PEN(11)) {
        OPQ_LANE();
        LAS float* scr = (LAS float*)(lds + wave * 16640);
        for (int it = gw; it < NL * IT_LAYER; it += NGW) {
            const int l = it / IT_LAYER; int r = it - l * IT_LAYER; unsigned char* wl = ws + WS_W + (size_t)l * WL_SZ;
            if (r < IT_IN) { transpose_item(args.in[I_WIN] + (size_t)l * DM * INW, INW, (r >> 7) * 64, (r & 127) * 64, args.in[I_NMIX] + l * DM, (bf16_t*)(wl + WL_IN), DM, 1, scr, lane); continue; } r -= IT_IN;
            if (r < IT_BR) { const int n = r >> 8, q = r & 255; transpose_item(args.in[I_WBR] + (size_t)(l * 2 + n) * DM * DM, DM, (q >> 4) * 64, (q & 15) * 64, nullptr, (bf16_t*)(wl + WL_BR) + (size_t)n * DM * DM, DM, 0, scr, lane); continue; } r -= IT_BR;
            if (r < IT_SQ) { transpose_item(args.in[I_WO] + (size_t)l * DM * DM, DM, (r >> 4) * 64, (r & 15) * 64, nullptr, (bf16_t*)(wl + WL_O), DM, 0, scr, lane); continue; } r -= IT_SQ;
            if (r < IT_SQ) { transpose_item(args.in[I_WCQ] + (size_t)l * DM * DM, DM, (r >> 4) * 64, (r & 15) * 64, args.in[I_NCROSS] + l * DM, (bf16_t*)(wl + WL_CQ), DM, 0, scr, lane); continue; } r -= IT_SQ;
            if (r < IT_KV) { transpose_item(args.in[I_WCKV] + (size_t)l * DM * 2048, 2048, (r >> 5) * 64, (r & 31) * 64, nullptr, (bf16_t*)(wl + WL_CKV), DM, 0, scr, lane); continue; } r -= IT_KV;
            if (r < IT_SQ) { transpose_item(args.in[I_WCO] + (size_t)l * DM * DM, DM, (r >> 4) * 64, (r & 15) * 64, nullptr, (bf16_t*)(wl + WL_CO), DM, 0, scr, lane); continue; } r -= IT_SQ;
            const int e = r / IT_EXP, r3 = r - e * IT_EXP, ty = r3 / 192, r4 = r3 - ty * 192;
            if (ty < 2) transpose_item(args.in[ty == 0 ? I_WG : I_WU] + (size_t)(l * NE + e) * DM * DE, DE, (r4 / 12) * 64, (r4 % 12) * 64, args.in[I_NFFN] + l * DM, (bf16_t*)(wl + WL_GU) + (size_t)e * 1536 * DM, DM, 2 + ty, scr, lane);
            else transpose_item(args.in[I_WD] + (size_t)(l * NE + e) * DE * DM, DM, (r4 >> 4) * 64, (r4 & 15) * 64, nullptr, (bf16_t*)(wl + WL_DN) + (size_t)e * DM * DE, DE, 0, scr, lane);
        }
        for (int m = gw; m < MT; m += NGW) memn_row(args.in[I_MEM] + (size_t)m * DM, args.in[I_NMEM], memn + (size_t)m * DM, lane);
        for (int m = gw; m < T; m += NGW) x0_row(args.in[I_X] + (size_t)m * DM, XB + (size_t)m * DM, part + (size_t)m * 16, lane);
        for (int i = vcu * 512 + tid; i < SEQ * 8; i += G * 512) rope_entry(i, cosT, sinT);
    }
    SEAM(0);

    for (int l = 0; l < NL; ++l) {
        const int pb = 1 + NPH_L * l;
        unsigned char* wl = ws + WS_W + (size_t)l * WL_SZ;
        const float* xin = (l == 0) ? args.in[I_X] : xs;
        unsigned* ecnt = ctl + CW_ECNT + l * 32 * 64;
        if (IN(pb + 0) && PEN(0)) {
            { DenseSched S; S.init(XB, wl + WL_IN, T, INW, DM, DM, G, bx);
              EpiIn E{part, cosT, sinT, Qb, Kb, Vb, Ub, CBb, Gb};
              pg8::gemm_phase<EpiIn, DenseSched, false, true>(lds, DM, DM, S, E); }
            if (l == 0) { KvcSched S{(const char*)memn, (const char*)(ws + WS_W + WL_CKV), G, bx};
              EpiPlain E{KVC, 2048, nullptr, 1.0f, (size_t)MT * 2048};
              pg8::gemm_phase<EpiPlain, KvcSched, false, true>(lds, DM, DM, S, E); }
        }
        SEAM(pb + 0);
        if (IN(pb + 1) && PEN(1)) {
            OPQ_LANE();
            conv_rows(Ub, CBb, args.in[I_CONVW] + (size_t)l * 3 * DM, YC, gw, NGW, lane);
            const float s1 = wave_sum(args.in[I_LQ1][l * 64 + lane] * args.in[I_LK1][l * 64 + lane]), s2 = wave_sum(args.in[I_LQ2][l * 64 + lane] * args.in[I_LK2][l * 64 + lane]);
            const float li = lambda_init(l), lam = expf(s1) - expf(s2) + li;
            for (int u = vcu; u < NB * NHD * 8; u += G) { const int bh = u >> 3, qb = u & 7;
                att::diff_unit(bh >> 3, bh & 7, qb, Qb, Kb, Vb, YA, lam, 1.0f - li, args.in[I_SUBLN] + l * 128, (char*)lds_raw); }
            __syncthreads();
        }
        SEAM(pb + 1);
        if (IN(pb + 2) && PEN(2)) {
            BrSched S; S.d.init(YA, wl + WL_BR, T, DM, DM, DM, G, bx); S.A1 = (const char*)YC; S.B1 = (const char*)(wl + WL_BR) + (size_t)DM * DM * 2;
            EpiBr E{Gb, Mb};
            pg8::gemm_phase<EpiBr, BrSched, false, true>(lds, DM, DM, S, E);
        }
        SEAM(pb + 2);
        if (IN(pb + 3) && PEN(3)) {
            DenseSched S; S.init(Mb, wl + WL_O, T, DM, DM, DM, G, bx);
            EpiRes E{xin, xs, XB, part};
            pg8::gemm_phase<EpiRes, DenseSched, false, true>(lds, DM, DM, S, E);
        }
        SEAM(pb + 3);
        if (IN(pb + 4) && PEN(4)) {
            DenseSched S; S.init(XB, wl + WL_CQ, T, DM, DM, DM, G, bx);
            EpiPlain E{QC, DM, part, CQSCALE, 0};
            pg8::gemm_phase<EpiPlain, DenseSched, false, true>(lds, DM, DM, S, E);
        }
        SEAM(pb + 4);
        if (IN(pb + 5) && PEN(5)) {
            for (int u = vcu; u < NB * 4 * 16; u += G) { const int bh = u >> 4, qb = u & 15;
                att::cross_unit(bh >> 2, bh & 3, qb, QC, KVC + (size_t)l * MT * 2048, OC, (char*)lds_raw); }
        }
        SEAM(pb + 5);
        if (IN(pb + 6) && PEN(6)) {
            DenseSched S; S.init(OC, wl + WL_CO, T, DM, DM, DM, G, bx);
            EpiRes E{xs, xs, XB, part};
            pg8::gemm_phase<EpiRes, DenseSched, false, true>(lds, DM, DM, S, E);
        }
        SEAM(pb + 6);
        if (IN(pb + 7) && PEN(7)) {
            OPQ_LANE();
            const float* We = args.in[I_WRE] + (size_t)l * DM * NE;
            for (int i = tid; i < DM * 8; i += 512) { const int k = i >> 3, c = i & 7; *(LAS f32x4*)(lds + k * 128 + ((c ^ ((k >> 1) & 7)) << 4)) = *(const f32x4*)(We + k * 32 + c * 4); }
            float gf[16]; f32x4 wg[16];
#pragma unroll
            for (int j = 0; j < 16; ++j) { gf[j] = args.in[I_NFFN][l * DM + j * 64 + lane]; wg[j] = *(const f32x4*)(args.in[I_WRG] + (size_t)l * DM * 4 + (j * 64 + lane) * 4); }
            __syncthreads();
            for (int t = gw; t < T; t += NGW) route_token(t, xs, part, gf, wg, (const LAS char*)lds, ecnt, elist, tok_e, tok_pos, tok_w, lane);
            __syncthreads();
        }
        SEAM(pb + 7);
        if (IN(pb + 8) || IN(pb + 9) || IN(pb + 10)) {
            OPQ_LANE();
            if (tid < 32) cntL[tid] = (int)__hip_atomic_load(ecnt + tid * 64, __ATOMIC_RELAXED, __HIP_MEMORY_SCOPE_AGENT);
            __syncthreads();
            if (tid == 0) { int a = 0;
#pragma unroll 1
                for (int e = 0; e < 32; ++e) { bst[e] = a; const int nb = (cntL[e] + 255) >> 8;
#pragma unroll 1
                    for (int q = 0; q < nb; ++q) bexp[a + q] = e;
                    a += nb; }
                bst[32] = a; }
            __syncthreads();
        }
        if (IN(pb + 8) && PEN(8)) {
            MoeSched S{bst, cntL, bexp, (const char*)XB, (const char*)(wl + WL_GU), elist, (size_t)1536 * DM * 2, (size_t)256 * DM * 2, 6, G, vcu, true};
            EpiGU E{part, ACT};
            pg8::gemm_phase<EpiGU, MoeSched, true, true>(lds, DM, DM, S, E);
        }
        SEAM(pb + 8);
        if (IN(pb + 9) && PEN(9)) {
            MoeSched S{bst, cntL, bexp, (const char*)ACT, (const char*)(wl + WL_DN), elist, (size_t)DM * DE * 2, (size_t)256 * DE * 2, 4, G, vcu, false};
            EpiPlain E{Yb, DM, nullptr, 1.0f, 0};
            pg8::gemm_phase<EpiPlain, MoeSched, false, true>(lds, DE, DE, S, E);
        }
        SEAM(pb + 9);
        if (IN(pb + 10) && PEN(10)) {
            OPQ_LANE();
            for (int t = gw; t < T; t += NGW) combine_row(t, bst, tok_e, tok_pos, tok_w, Yb, xs, XB, part, args.in[I_NFIN], l == NL - 1, lane);
        }
        SEAM(pb + 10);
    }
#undef IN
#undef SEAM
#undef GRID_BAR
}

extern "C" void kernel_launch(void* const* d_in, const int* in_sizes, int n_in, void* d_out, int out_size, void* d_ws, size_t ws_size, hipStream_t stream) {
    static int grid = 0;
    if (grid == 0) {
        if (n_in != 24 || in_sizes[0] != T * DM || out_size != T * DM || ws_size < WS_END) {
            fprintf(stderr, "kernel_launch: shape mismatch: n_in %d in0 %d out %d ws %zu (need >= %zu); nothing launched\n", n_in, n_in > 0 ? in_sizes[0] : -1, out_size, ws_size, (size_t)WS_END); grid = -1; return; }
        int dev = 0, cus = 0, per_cu = 0;
        if (hipGetDevice(&dev) != hipSuccess || hipDeviceGetAttribute(&cus, hipDeviceAttributeMultiprocessorCount, dev) != hipSuccess) { fprintf(stderr, "kernel_launch: device query failed\n"); grid = -1; return; }
        if (hipFuncSetAttribute((const void*)fwd, hipFuncAttributeMaxDynamicSharedMemorySize, LDS_BYTES) != hipSuccess) { fprintf(stderr, "kernel_launch: hipFuncSetAttribute failed\n"); grid = -1; return; }
        if (hipOccupancyMaxActiveBlocksPerMultiprocessor(&per_cu, (const void*)fwd, 512, LDS_BYTES) != hipSuccess || per_cu < 1)
            fprintf(stderr, "kernel_launch: note: occupancy query reports %d workgroups per CU\n", per_cu);
        (void)hipGetLastError();
        grid = cus;
    }
    if (grid < 0) return;
    if (hipMemsetAsync((char*)d_ws + WS_CTL, 0, CTL_ZERO_BYTES, stream) != hipSuccess) { fprintf(stderr, "kernel_launch: memset failed\n"); return; }
    Args a{};
    for (int i = 0; i < 24; ++i) a.in[i] = (const float*)d_in[i];
    a.out = (float*)d_out; a.ws = (unsigned char*)d_ws;
#if MK_SPLIT
    for (int ph = 0; ph < NPHASE; ++ph) { a.ph_lo = ph; a.ph_hi = ph + 1; hipLaunchKernelGGL(fwd, dim3(grid), dim3(512), LDS_BYTES, stream, a); }
#else
    a.ph_lo = 0; a.ph_hi = NPHASE; hipLaunchKernelGGL(fwd, dim3(grid), dim3(512), LDS_BYTES, stream, a);
#endif
    const hipError_t le = hipPeekAtLastError();
    if (le != hipSuccess) fprintf(stderr, "kernel_launch: launch failed: %s\n", hipGetErrorName(le));
}
```

```cpp
#include <hip/hip_runtime.h>
#include <cstdio>
#include <cstdint>

#ifndef MK_SPLIT
#define MK_SPLIT 0
#endif

#define LAS __attribute__((address_space(3)))
#define GAS __attribute__((address_space(1)))
typedef unsigned short bf16_t;
typedef short bf16x8 __attribute__((ext_vector_type(8)));
typedef short s16x4 __attribute__((ext_vector_type(4)));
typedef float f32x2 __attribute__((ext_vector_type(2)));
typedef float f32x4 __attribute__((ext_vector_type(4)));
typedef float f32x16 __attribute__((ext_vector_type(16)));
typedef unsigned u32x2 __attribute__((ext_vector_type(2)));
typedef unsigned u32x4 __attribute__((ext_vector_type(4)));

constexpr int T = 16384, DM = 1024, NB = 8, SEQ = 2048, NL = 4, NMEM = 256, MT = NB * NMEM;
constexpr int INW = 8192, NE = 32, DE = 768, NHD = 8;
constexpr float EPS = 1e-6f;
constexpr float QSCALE = 0.18033688011112042f;
constexpr float CQSCALE = 0.09016844005556021f;
constexpr int MAXROWS = 40960;
constexpr int NPH_L = 11, NPHASE = 1 + NL * NPH_L;

constexpr size_t MiB = 1u << 20;
constexpr size_t WS_CTL = 0, CTL_ZERO_BYTES = 1 * MiB;
constexpr size_t WS_ROPE = 1 * MiB;
constexpr size_t WS_PART = 2 * MiB;
constexpr size_t WS_TOK = 3 * MiB;
constexpr size_t WS_ELIST = 4 * MiB;
constexpr size_t WS_MEMN = 6 * MiB;
constexpr size_t WS_KVC = 10 * MiB;
constexpr size_t WS_XB = 42 * MiB;
constexpr size_t WS_Q = 74 * MiB, WS_K = 106 * MiB, WS_V = 138 * MiB, WS_U = 170 * MiB, WS_CB = 202 * MiB;
constexpr size_t WS_G = 234 * MiB;
constexpr size_t WS_YA = 298 * MiB, WS_YC = 330 * MiB, WS_M = 362 * MiB;
constexpr size_t WS_QC = WS_Q, WS_OC = WS_K;
constexpr size_t WS_ACT = 394 * MiB;
constexpr size_t WS_Y = 454 * MiB;
constexpr size_t WS_W = 534 * MiB;
constexpr size_t WL_IN = 0, WL_BR = 16 * MiB, WL_O = 20 * MiB, WL_CQ = 22 * MiB, WL_CKV = 24 * MiB, WL_CO = 28 * MiB, WL_GU = 30 * MiB, WL_DN = 126 * MiB, WL_SZ = 174 * MiB;
constexpr size_t WS_END = WS_W + NL * WL_SZ;
constexpr size_t WS_DUMMY = WS_END;
constexpr int CW_BAR = 4096;
constexpr int CW_ECNT = 16384;

constexpr int RING_BYTES = 131072;
constexpr int LDSCTL_OFF = 145408;
constexpr int LDS_BYTES = 147456;
constexpr int LC_MISC = LDSCTL_OFF;
constexpr int LC_BST = LDSCTL_OFF + 256, LC_CNT = LDSCTL_OFF + 512, LC_BEXP = LDSCTL_OFF + 1024;

__device__ __forceinline__ unsigned cvt_pk_bf16(float lo, float hi) { unsigned r; asm volatile("v_cvt_pk_bf16_f32 %0, %1, %2" : "=v"(r) : "v"(lo), "v"(hi)); return r; }
__device__ __forceinline__ float bf_lo(unsigned w) { return __uint_as_float(w << 16); }
__device__ __forceinline__ float bf_hi(unsigned w) { return __uint_as_float(w & 0xffff0000u); }
template <int M> __device__ __forceinline__ float swz_xor(float v) { return __int_as_float(__builtin_amdgcn_ds_swizzle(__float_as_int(v), (M << 10) | 0x1f)); }
__device__ __forceinline__ float half_sum(float v) { auto rr = __builtin_amdgcn_permlane32_swap(__float_as_uint(v), __float_as_uint(v), false, false); return __uint_as_float(rr[0]) + __uint_as_float(rr[1]); }
__device__ __forceinline__ float sum32(float v) { v += swz_xor<1>(v); v += swz_xor<2>(v); v += swz_xor<4>(v); v += swz_xor<8>(v); v += swz_xor<16>(v); return v; }
__device__ __forceinline__ float wave_sum(float v) { return half_sum(sum32(v)); }
#define LDS_WAIT() asm volatile("s_waitcnt lgkmcnt(0)" ::: "memory")
#define VM_WAIT() asm volatile("s_waitcnt vmcnt(0)" ::: "memory")
__device__ __forceinline__ float lambda_init(int l) { return l == 0 ? 0.2f : l == 1 ? 0.35550906759096934f : l == 2 ? 0.4707130183435842f : 0.5560582041556406f; }
__device__ __forceinline__ float row_rscale(const float* part, int row) {
    const f32x4* p = (const f32x4*)(part + (size_t)row * 16);
    const f32x4 a = p[0], b = p[1], c = p[2], d = p[3];
    const float s = ((a[0] + a[1]) + (a[2] + a[3])) + ((b[0] + b[1]) + (b[2] + b[3])) + (((c[0] + c[1]) + (c[2] + c[3])) + ((d[0] + d[1]) + (d[2] + d[3])));
    return 1.0f / sqrtf(s * (1.0f / DM) + EPS);
}

__device__ __forceinline__ void row_rscale8(const float* part, const int (&rows)[2][4], int fq, float (&rs)[2][4]) {
    f32x4 v[2][4];
#pragma unroll
    for (int ai = 0; ai < 2; ++ai)
#pragma unroll
        for (int m = 0; m < 4; ++m) v[ai][m] = *(const f32x4*)(part + (size_t)rows[ai][m] * 16 + fq * 4);
#pragma unroll
    for (int ai = 0; ai < 2; ++ai)
#pragma unroll
        for (int m = 0; m < 4; ++m) { float s = (v[ai][m][0] + v[ai][m][1]) + (v[ai][m][2] + v[ai][m][3]); s += swz_xor<16>(s); s = half_sum(s); rs[ai][m] = 1.0f / sqrtf(s * (1.0f / DM) + EPS); }
}

namespace pg8 {
constexpr int BM = 256, BK = 64, HALF = 128, HTB = HALF * BK * 2, STAGE_BYTES = 8 * HTB;
__host__ __device__ __forceinline__ int lds_byte(int r, int c) { const int st = (r >> 4) * 2 + (c >> 5), rr = r & 15, cc = c & 31, ob = rr * 64 + cc * 2; return st * 1024 + (ob ^ (((ob >> 9) & 1) << 5)); }
__host__ __device__ __forceinline__ void stage_rc(int b, int& R, int& C) { const int st = b / 1024, sb = b % 1024, swz = sb ^ (((sb >> 9) & 1) << 5); R = (st >> 1) * 16 + swz / 64; C = (st & 1) * 32 + (swz % 64) / 2; }
__host__ __device__ __forceinline__ int perm32(int rho) { const int n = rho >> 4, i = rho & 15; return 8 * (i >> 2) + 4 * n + (i & 3); }

struct Unit { const char* A; const char* B; const int* gidx; int pm, pn, aux, nvalid; };

template <class Epi, class Sched, bool GATHER, bool ALIGN_EPI>
__device__ __forceinline__ void gemm_phase(LAS unsigned char* lds, const int K, const int lda, const Sched& S, const Epi& E) {
    int tid_ = threadIdx.x; asm volatile("" : "+v"(tid_));
    const int tid = tid_, wid = __builtin_amdgcn_readfirstlane(tid >> 6), lane = tid & 63, wr = wid >> 2, wc = wid & 3, fr = lane & 15, fq = lane >> 4;
    const int nt = K / BK;
    constexpr int NH = GATHER ? 2 : 1;
    unsigned voffB[2], voffA[NH][2], voffAn[NH][2];
#pragma unroll
    for (int i = 0; i < 2; ++i) { int R, C; stage_rc(tid * 16 + i * 8192, R, C); const int Rb = Epi::PERM ? ((R & ~31) + perm32(R & 31)) : R;
        voffB[i] = (unsigned)(Rb * K + C) * 2u; if constexpr (!GATHER) voffA[0][i] = (unsigned)(R * lda + C) * 2u; }
    const size_t kstep = (size_t)(BK * 2);
    const size_t hstepB = (size_t)HALF * K * 2, hstepA = GATHER ? 0 : (size_t)HALF * lda * 2;
    const unsigned ldsw = (unsigned)wid * 1024u;
    const int aoff = lds_byte(wr * 64 + fr, fq * 8), boff = lds_byte(wc * 32 + fr, fq * 8);
#define PG8_SA(b, h) (((b) * 2 + (h)) * HTB)
#define PG8_SB(b, h) ((4 + (b) * 2 + (h)) * HTB)
#define PG8_STAGE(bufoff, gbase, voff) do { _Pragma("unroll") for (int _i = 0; _i < 2; ++_i) \
        __builtin_amdgcn_global_load_lds((const unsigned*)((const char*)(gbase) + (voff)[_i]), (LAS unsigned*)(lds + (bufoff) + ldsw + _i * 8192), 16, 0, 0); } while (0)
#define PG8_STAGE_A(bufoff, gbase, h, nx) do { if constexpr (GATHER) { unsigned _v[2]; _v[0] = (nx) ? voffAn[h][0] : voffA[h][0]; _v[1] = (nx) ? voffAn[h][1] : voffA[h][1]; PG8_STAGE(bufoff, gbase, _v); } \
        else PG8_STAGE(bufoff, (gbase) + (h) * hstepA, voffA[0]); } while (0)
#define PG8_LDA(dst, b, h) do { _Pragma("unroll") for (int m = 0; m < 4; ++m) _Pragma("unroll") for (int k = 0; k < 2; ++k) dst[m][k] = *(const LAS bf16x8*)(lds + PG8_SA(b, h) + aoff + m * 2048 + k * 1024); } while (0)
#define PG8_LDB(dst, b, h) do { _Pragma("unroll") for (int n = 0; n < 2; ++n) _Pragma("unroll") for (int k = 0; k < 2; ++k) dst[n][k] = *(const LAS bf16x8*)(lds + PG8_SB(b, h) + boff + n * 2048 + k * 1024); } while (0)
#define PG8_MMA(ai, bj, At, Bt) do { __builtin_amdgcn_s_setprio(1); _Pragma("unroll") for (int m = 0; m < 4; ++m) _Pragma("unroll") for (int n = 0; n < 2; ++n) _Pragma("unroll") for (int k = 0; k < 2; ++k) \
        acc[ai][bj][m][n] = __builtin_amdgcn_mfma_f32_16x16x32_bf16(Bt[n][k], At[m][k], acc[ai][bj][m][n], 0, 0, 0); __builtin_amdgcn_s_setprio(0); } while (0)
#define PG8_WAIT_V(n) asm volatile("s_waitcnt vmcnt(" #n ")" ::: "memory")
#define PG8_WAIT_L(n) asm volatile("s_waitcnt lgkmcnt(" #n ")" ::: "memory")
#define PG8_BAR __builtin_amdgcn_s_barrier()
#define PG8_SCHED __builtin_amdgcn_sched_barrier(0)
#define PG8_VOFFA(dst, u) do { if constexpr (GATHER) { _Pragma("unroll") for (int _h = 0; _h < 2; ++_h) _Pragma("unroll") for (int _i = 0; _i < 2; ++_i) { \
        int _R, _C; stage_rc(tid * 16 + _i * 8192, _R, _C); const int _r = _h * HALF + _R; const int _t = (_r < (u).nvalid) ? (u).gidx[_r] : 0; dst[_h][_i] = (unsigned)(_t * lda + _C) * 2u; } } } while (0)
    Unit cur, nxt; int ui = 0;
    if (!S.next(0, cur)) return;
    PG8_VOFFA(voffA, cur);
    f32x4 acc[2][2][4][2];
#pragma unroll
    for (int a = 0; a < 2; ++a)
#pragma unroll
        for (int b = 0; b < 2; ++b)
#pragma unroll
            for (int m = 0; m < 4; ++m)
#pragma unroll
                for (int n = 0; n < 2; ++n) acc[a][b][m][n] = (f32x4){0.f, 0.f, 0.f, 0.f};
    bf16x8 At[4][2], B0[2][2], B1[2][2];
    const char* cA = cur.A; const char* cB = cur.B;
    PG8_STAGE(PG8_SB(0, 0), cB, voffB); PG8_STAGE(PG8_SB(0, 1), cB + hstepB, voffB); PG8_STAGE_A(PG8_SA(0, 0), cA, 0, false); PG8_STAGE_A(PG8_SA(0, 1), cA, 1, false);
    if (wr == 1) PG8_BAR;
    PG8_WAIT_V(2); PG8_BAR;
    PG8_STAGE(PG8_SB(1, 0), cB + kstep, voffB); PG8_STAGE_A(PG8_SA(1, 0), cA + kstep, 0, false); PG8_STAGE(PG8_SB(1, 1), cB + hstepB + kstep, voffB);
    PG8_WAIT_V(6); PG8_BAR;
    for (;;) {
        const bool has_next = S.next(ui + 1, nxt);
        if constexpr (GATHER) {
            if (has_next) { PG8_VOFFA(voffAn, nxt); }
            else {
#pragma unroll
                for (int h = 0; h < NH; ++h)
#pragma unroll
                    for (int i = 0; i < 2; ++i) voffAn[h][i] = voffA[h][i];
            }
        }
        const char* nA = has_next ? nxt.A : cA; const char* nB = has_next ? nxt.B : cB;
        for (int t = 0; t < nt; t += 2) {
            const bool last = (t == nt - 2);
            const char* a1 = cA + (size_t)(t + 1) * kstep;
            const char* a2 = last ? nA : cA + (size_t)(t + 2) * kstep; const char* b2 = last ? nB : cB + (size_t)(t + 2) * kstep;
            const char* a3 = a2 + kstep; const char* b3 = b2 + kstep;
            PG8_LDB(B0, 0, 0); PG8_LDB(B1, 0, 1); PG8_SCHED; PG8_LDA(At, 0, 0); PG8_STAGE_A(PG8_SA(1, 1), a1, 1, false);
            PG8_WAIT_V(8); PG8_WAIT_L(0); PG8_BAR; PG8_MMA(0, 0, At, B0); PG8_MMA(0, 1, At, B1); PG8_BAR; PG8_SCHED;
            PG8_LDA(At, 0, 1); PG8_STAGE(PG8_SB(0, 0), b2, voffB); PG8_STAGE(PG8_SB(0, 1), b2 + hstepB, voffB); PG8_STAGE_A(PG8_SA(0, 0), a2, 0, last);
            PG8_WAIT_V(8); PG8_WAIT_L(0); PG8_BAR; PG8_MMA(1, 0, At, B0); PG8_MMA(1, 1, At, B1); PG8_BAR; PG8_SCHED;
            PG8_LDB(B0, 1, 0); PG8_LDB(B1, 1, 1); PG8_SCHED; PG8_LDA(At, 1, 0); PG8_STAGE_A(PG8_SA(0, 1), a2, 1, last);
            PG8_WAIT_V(8); PG8_WAIT_L(0); PG8_BAR; PG8_MMA(0, 0, At, B0); PG8_MMA(0, 1, At, B1); PG8_BAR; PG8_SCHED;
            PG8_LDA(At, 1, 1); PG8_STAGE(PG8_SB(1, 0), b3, voffB); PG8_STAGE(PG8_SB(1, 1), b3 + hstepB, voffB); PG8_STAGE_A(PG8_SA(1, 0), a3, 0, last);
            PG8_WAIT_V(8); PG8_WAIT_L(0); PG8_BAR; PG8_MMA(1, 0, At, B0); PG8_MMA(1, 1, At, B1); PG8_BAR; PG8_SCHED;
        }
        if constexpr (ALIGN_EPI) { if (wr == 0) PG8_BAR; }
        const bool keep = E(acc, cur, wr, wc, fr, fq);
        if (!has_next) break;
        if (!keep) {
#pragma unroll
            for (int a = 0; a < 2; ++a)
#pragma unroll
                for (int b = 0; b < 2; ++b)
#pragma unroll
                    for (int m = 0; m < 4; ++m)
#pragma unroll
                        for (int n = 0; n < 2; ++n) acc[a][b][m][n] = (f32x4){0.f, 0.f, 0.f, 0.f};
        }
        cur = nxt; cA = nA; cB = nB; ++ui;
        if constexpr (GATHER) {
#pragma unroll
            for (int h = 0; h < NH; ++h)
#pragma unroll
                for (int i = 0; i < 2; ++i) voffA[h][i] = voffAn[h][i];
        }
        if constexpr (ALIGN_EPI) { if (wr == 1) PG8_BAR; }
    }
    PG8_WAIT_V(0);
    if constexpr (!ALIGN_EPI) { if (wr == 0) PG8_BAR; }
    PG8_BAR;
#undef PG8_SA
#undef PG8_SB
#undef PG8_STAGE
#undef PG8_STAGE_A
#undef PG8_LDA
#undef PG8_LDB
#undef PG8_MMA
#undef PG8_WAIT_V
#undef PG8_WAIT_L
#undef PG8_BAR
#undef PG8_SCHED
#undef PG8_VOFFA
}
}

struct DenseSched {
    const char* A; const char* B; size_t astep, bstep; int nM, nN, nwg, G, c;
    __device__ __forceinline__ void init(const void* A_, const void* B_, int M, int N, int K, int lda, int G_, int c_) {
        A = (const char*)A_; B = (const char*)B_; astep = (size_t)256 * lda * 2; bstep = (size_t)256 * K * 2; nM = M / 256; nN = N / 256; nwg = nM * nN; G = G_; c = c_; }
    __device__ __forceinline__ bool next(int i, pg8::Unit& u) const {
        const long L = (long)i * G + c; if (L >= nwg) return false;
        int wgid = (int)L; { const int q = nwg / 8, r = nwg % 8, xcd = wgid % 8, off = wgid / 8; wgid = (xcd < r ? xcd * (q + 1) : r * (q + 1) + (xcd - r) * q) + off; }
        const int nig = 8 * nN, gid = wgid / nig, fm = gid * 8, gsz = (nM - fm) < 8 ? (nM - fm) : 8;
        u.pm = fm + ((wgid % nig) % gsz); u.pn = (wgid % nig) / gsz; u.aux = 0; u.gidx = nullptr; u.nvalid = 256;
        u.A = A + (size_t)u.pm * astep; u.B = B + (size_t)u.pn * bstep; return true;
    }
};
struct BrSched {
    DenseSched d; const char* A1; const char* B1;
    __device__ __forceinline__ bool next(int i, pg8::Unit& u) const {
        if (!d.next(i >> 1, u)) return false;
        if (i & 1) { u.A = A1 + (size_t)u.pm * d.astep; u.B = B1 + (size_t)u.pn * d.bstep; u.aux = 1; }
        return true;
    }
};
struct KvcSched {
    const char* A; const char* B; int G, c;
    __device__ __forceinline__ bool next(int i, pg8::Unit& u) const {
        const int L = i * G + c; if (L >= 256) return false;
        const int l = L >> 6, r = L & 63; u.pm = r & 7; u.pn = r >> 3; u.aux = l; u.gidx = nullptr; u.nvalid = 256;
        u.A = A + (size_t)u.pm * (256 * DM * 2); u.B = B + (size_t)l * WL_SZ + (size_t)u.pn * (256 * DM * 2); return true;
    }
};
struct MoeSched {
    const LAS int* bst; const LAS int* cnt; const LAS int* bexp; const char* A; const char* B; const int* elist; size_t estride, tstride; int ntile, G, c; bool gather;
    __device__ __forceinline__ bool next(int i, pg8::Unit& u) const {
        const int nblk = bst[32]; const int L = i * G + c; if (L >= nblk * ntile) return false;
        const int blk = L / ntile, j = L - blk * ntile;
        const int e = __builtin_amdgcn_readfirstlane(bexp[blk]);
        const int rb = blk - __builtin_amdgcn_readfirstlane(bst[e]); const int ce = __builtin_amdgcn_readfirstlane(cnt[e]);
        u.pm = blk; u.pn = j; u.aux = e; u.nvalid = (ce - rb * 256) < 256 ? (ce - rb * 256) : 256;
        u.gidx = elist + (size_t)e * T + rb * 256;
        u.A = gather ? A : A + (size_t)blk * 256 * DE * 2;
        u.B = B + (size_t)e * estride + (size_t)j * tstride; return true;
    }
};

__device__ __forceinline__ void st8(bf16_t* p, f32x4 v0, f32x4 v1) {
    u32x4 w; w.x = cvt_pk_bf16(v0[0], v0[1]); w.y = cvt_pk_bf16(v0[2], v0[3]); w.z = cvt_pk_bf16(v1[0], v1[1]); w.w = cvt_pk_bf16(v1[2], v1[3]); *(u32x4*)p = w; }
__device__ __forceinline__ float sigmoidf_(float x) { return 1.0f / (1.0f + __expf(-x)); }

struct EpiIn {
    static constexpr bool PERM = true;
    const float* part; const float* cosT; const float* sinT; bf16_t *Q, *Kb, *V, *U, *CB, *G;
    __device__ __forceinline__ bool operator()(f32x4 (&acc)[2][2][4][2], const pg8::Unit& u, int wr, int wc, int fr, int fq) const {
        const int pn = u.pn, row0 = u.pm * 256 + wr * 64 + fr;
        float rs_[2][4]; { int rows_[2][4];
#pragma unroll
            for (int ai = 0; ai < 2; ++ai)
#pragma unroll
                for (int m = 0; m < 4; ++m) rows_[ai][m] = row0 + ai * 128 + m * 16;
            row_rscale8(part, rows_, fq, rs_); }
#define RS_AT(ai, m) rs_[ai][m]
#define EFENCE() asm volatile("" ::: "memory")
        if (pn < 8) {
            bf16_t* dst = pn < 4 ? Q : Kb; const float sc = pn < 4 ? QSCALE : 1.0f; const int colb = (pn & 3) * 256 + wc * 32 + 8 * fq;
            const bool rot = ((wc & 1) == 0) && (fq < 2);
#pragma unroll
            for (int ai = 0; ai < 2; ++ai)
#pragma unroll
                for (int m = 0; m < 4; ++m) { const int row = row0 + ai * 128 + m * 16; f32x4 c4 = {1.f, 1.f, 1.f, 1.f}, s4 = {0.f, 0.f, 0.f, 0.f}; const float rsv = RS_AT(ai, m);
                    if (rot) { const int t = row & (SEQ - 1); c4 = *(const f32x4*)(cosT + t * 8 + 4 * fq); s4 = *(const f32x4*)(sinT + t * 8 + 4 * fq); }
#pragma unroll
                    for (int bj = 0; bj < 2; ++bj) { f32x4 x1 = acc[ai][bj][m][0] * rsv, x2 = acc[ai][bj][m][1] * rsv;
                        const f32x4 y1 = x1 * c4 - x2 * s4, y2 = x2 * c4 + x1 * s4;
                        if (rot) { x1 = y1; x2 = y2; }
                        st8(dst + (size_t)row * DM + colb + bj * 128, x1 * sc, x2 * sc); } EFENCE(); }
        } else if (pn < 16) {
            bf16_t* dst = pn < 12 ? V : CB; const int colb = (pn & 3) * 256 + wc * 32 + 8 * fq;
#pragma unroll
            for (int ai = 0; ai < 2; ++ai)
#pragma unroll
                for (int m = 0; m < 4; ++m) { const int row = row0 + ai * 128 + m * 16; const float rsv = RS_AT(ai, m);
#pragma unroll
                    for (int bj = 0; bj < 2; ++bj) st8(dst + (size_t)row * DM + colb + bj * 128, acc[ai][bj][m][0] * rsv, acc[ai][bj][m][1] * rsv); EFENCE(); }
        } else if (pn < 24) {
            const int colb = (pn - 16) * 128 + wc * 32 + 8 * fq;
#pragma unroll
            for (int ai = 0; ai < 2; ++ai)
#pragma unroll
                for (int m = 0; m < 4; ++m) { const int row = row0 + ai * 128 + m * 16; const float rsv = RS_AT(ai, m); const float r2 = rsv * rsv;
                    st8(U + (size_t)row * DM + colb, acc[ai][0][m][0] * acc[ai][1][m][0] * r2, acc[ai][0][m][1] * acc[ai][1][m][1] * r2); EFENCE(); }
        } else {
            const int colb = (pn - 24) * 256 + wc * 32 + 8 * fq;
#pragma unroll
            for (int ai = 0; ai < 2; ++ai)
#pragma unroll
                for (int m = 0; m < 4; ++m) { const int row = row0 + ai * 128 + m * 16; const float rsv = RS_AT(ai, m);
#pragma unroll
                    for (int bj = 0; bj < 2; ++bj) { f32x4 a = acc[ai][bj][m][0] * rsv, b = acc[ai][bj][m][1] * rsv;
#pragma unroll
                        for (int j = 0; j < 4; ++j) { a[j] = sigmoidf_(a[j]); b[j] = sigmoidf_(b[j]); }
                        st8(G + (size_t)row * 2048 + colb + bj * 128, a, b); } EFENCE(); }
        }
#undef RS_AT
        return false;
    }
};
struct EpiPlain {
    static constexpr bool PERM = true;
    bf16_t* O; int ldc; const float* part; float scale; size_t aux_stride;
    __device__ __forceinline__ bool operator()(f32x4 (&acc)[2][2][4][2], const pg8::Unit& u, int wr, int wc, int fr, int fq) const {
        const int row0 = u.pm * 256 + wr * 64 + fr, colb = u.pn * 256 + wc * 32 + 8 * fq; bf16_t* base = O + (size_t)u.aux * aux_stride;
        float rs_[2][4];
        if (part) { int rows_[2][4];
#pragma unroll
            for (int ai = 0; ai < 2; ++ai)
#pragma unroll
                for (int m = 0; m < 4; ++m) rows_[ai][m] = row0 + ai * 128 + m * 16;
            row_rscale8(part, rows_, fq, rs_); }
#pragma unroll
        for (int ai = 0; ai < 2; ++ai)
#pragma unroll
            for (int m = 0; m < 4; ++m) { const int row = row0 + ai * 128 + m * 16; const float s = part ? rs_[ai][m] * scale : scale;
#pragma unroll
                for (int bj = 0; bj < 2; ++bj) st8(base + (size_t)row * ldc + colb + bj * 128, acc[ai][bj][m][0] * s, acc[ai][bj][m][1] * s); }
        return false;
    }
};
struct EpiRes {
    static constexpr bool PERM = false;
    const float* xin; float* xout; bf16_t* xb; float* part;
    __device__ __forceinline__ bool operator()(f32x4 (&acc)[2][2][4][2], const pg8::Unit& u, int wr, int wc, int fr, int fq) const {
        const int row0 = u.pm * 256 + wr * 64 + fr, col0 = u.pn * 256 + wc * 32 + 4 * fq;
#pragma unroll
        for (int ai = 0; ai < 2; ++ai)
#pragma unroll
            for (int m = 0; m < 4; ++m) { const int row = row0 + ai * 128 + m * 16; float ss = 0.f;
#pragma unroll
                for (int bj = 0; bj < 2; ++bj)
#pragma unroll
                    for (int n = 0; n < 2; ++n) { const size_t off = (size_t)row * DM + col0 + bj * 128 + n * 16;
                        const f32x4 xv = *(const f32x4*)(xin + off) + acc[ai][bj][m][n]; *(f32x4*)(xout + off) = xv;
                        ss += (xv[0] * xv[0] + xv[1] * xv[1]) + (xv[2] * xv[2] + xv[3] * xv[3]);
                        u32x2 w; w.x = cvt_pk_bf16(xv[0], xv[1]); w.y = cvt_pk_bf16(xv[2], xv[3]); *(u32x2*)(xb + off) = w; }
                ss += swz_xor<16>(ss); ss = half_sum(ss);
                if (fq == 0) part[(size_t)row * 16 + u.pn * 4 + wc] = ss; }
        return false;
    }
};
struct EpiBr {
    static constexpr bool PERM = true;
    const bf16_t* G; bf16_t* Mo;
    __device__ __forceinline__ bool operator()(f32x4 (&acc)[2][2][4][2], const pg8::Unit& u, int wr, int wc, int fr, int fq) const {
        const int row0 = u.pm * 256 + wr * 64 + fr, colb = u.pn * 256 + wc * 32 + 8 * fq; const bool first = (u.aux == 0);
#pragma unroll
        for (int ai = 0; ai < 2; ++ai)
#pragma unroll
            for (int m = 0; m < 4; ++m) { const int row = row0 + ai * 128 + m * 16;
#pragma unroll
                for (int bj = 0; bj < 2; ++bj) { const u32x4 g0 = *(const u32x4*)(G + (size_t)row * 2048 + colb + bj * 128), g1 = *(const u32x4*)(G + (size_t)row * 2048 + 1024 + colb + bj * 128);
                    f32x4 a0 = {bf_lo(g0.x), bf_hi(g0.x), bf_lo(g0.y), bf_hi(g0.y)}, a1 = {bf_lo(g0.z), bf_hi(g0.z), bf_lo(g0.w), bf_hi(g0.w)};
                    f32x4 b0 = {bf_lo(g1.x), bf_hi(g1.x), bf_lo(g1.y), bf_hi(g1.y)}, b1 = {bf_lo(g1.z), bf_hi(g1.z), bf_lo(g1.w), bf_hi(g1.w)};
                    if (first) {
#pragma unroll
                        for (int j = 0; j < 4; ++j) { acc[ai][bj][m][0][j] *= a0[j] / b0[j]; acc[ai][bj][m][1][j] *= a1[j] / b1[j]; }
                    } else st8(Mo + (size_t)row * DM + colb + bj * 128, acc[ai][bj][m][0] * b0, acc[ai][bj][m][1] * b1); } }
        return first;
    }
};
struct EpiGU {
    static constexpr bool PERM = true;
    const float* part; bf16_t* ACT;
    __device__ __forceinline__ bool operator()(f32x4 (&acc)[2][2][4][2], const pg8::Unit& u, int wr, int wc, int fr, int fq) const {
        const int colb = u.pn * 128 + wc * 32 + 8 * fq;
        float rs_[2][4]; { int rows_[2][4];
#pragma unroll
            for (int ai = 0; ai < 2; ++ai)
#pragma unroll
                for (int m = 0; m < 4; ++m) { const int rl = ai * 128 + wr * 64 + m * 16 + fr; rows_[ai][m] = (rl < u.nvalid) ? u.gidx[rl] : 0; }
            row_rscale8(part, rows_, fq, rs_); }
#pragma unroll
        for (int ai = 0; ai < 2; ++ai)
#pragma unroll
            for (int m = 0; m < 4; ++m) { const int rl = ai * 128 + wr * 64 + m * 16 + fr; const float s = rs_[ai][m];
                f32x4 o[2];
#pragma unroll
                for (int n = 0; n < 2; ++n) { const f32x4 g = acc[ai][0][m][n] * s, up = acc[ai][1][m][n] * s;
#pragma unroll
                    for (int j = 0; j < 4; ++j) o[n][j] = g[j] * sigmoidf_(g[j]) * up[j]; }
                st8(ACT + (size_t)(u.pm * 256 + rl) * DE + colb, o[0], o[1]); }
        return false;
    }
};

namespace att {
#define SBAR() __builtin_amdgcn_sched_barrier(0)
constexpr float THR2 = 11.541560327111707f;
__device__ __forceinline__ int crow(int r, int hi) { return (r & 3) + 8 * (r >> 2) + 4 * hi; }
template <int DQK> __device__ __forceinline__ int kswz(int row, int colB) {
    if constexpr (DQK == 64) return row * 128 + (colB ^ (((row >> 1) & 7) << 4));
    else return row * 512 + (colB ^ ((row & 15) << 4));
}
__device__ __forceinline__ void partialSM(f32x16& p0, f32x16& p1, float& m_reg, float& mn, float& alpha) {
    float pmax = p0[0];
#pragma unroll
    for (int r = 1; r < 16; ++r) pmax = fmaxf(pmax, p0[r]);
#pragma unroll
    for (int r = 0; r < 16; ++r) pmax = fmaxf(pmax, p1[r]);
    { auto rr = __builtin_amdgcn_permlane32_swap(__float_as_uint(pmax), __float_as_uint(pmax), false, false);
      pmax = fmaxf(__uint_as_float(rr[0]), __uint_as_float(rr[1])); }
    if (__builtin_expect(__all(pmax - m_reg <= THR2), 1)) { mn = m_reg; alpha = 1.f; }
    else { mn = fmaxf(m_reg, pmax); alpha = __builtin_amdgcn_exp2f(m_reg - mn); m_reg = mn; }
#pragma unroll
    for (int r = 0; r < 16; ++r) p0[r] = p0[r] - mn;
#pragma unroll
    for (int r = 0; r < 16; ++r) p1[r] = p1[r] - mn;
#pragma unroll
    for (int r = 0; r < 16; ++r) p0[r] = __builtin_amdgcn_exp2f(p0[r]);
}
__device__ __forceinline__ void finishSM(f32x16& p0, f32x16& p1, float alpha, float& l_reg, bf16x8& pa0, bf16x8& pa1, bf16x8& pa2, bf16x8& pa3) {
#pragma unroll
    for (int r = 0; r < 16; ++r) p1[r] = __builtin_amdgcn_exp2f(p1[r]);
    float ps = 0;
#pragma unroll
    for (int r = 0; r < 16; ++r) ps += p0[r];
#pragma unroll
    for (int r = 0; r < 16; ++r) ps += p1[r];
    { auto rr = __builtin_amdgcn_permlane32_swap(__float_as_uint(ps), __float_as_uint(ps), false, false);
      ps = __uint_as_float(rr[0]) + __uint_as_float(rr[1]); }
    l_reg = l_reg * alpha + ps;
#define PK4(P, BASE, OUT) do { unsigned a0 = cvt_pk_bf16(P[BASE + 0], P[BASE + 1]), a1 = cvt_pk_bf16(P[BASE + 2], P[BASE + 3]);   \
    unsigned b0 = cvt_pk_bf16(P[BASE + 4], P[BASE + 5]), b1 = cvt_pk_bf16(P[BASE + 6], P[BASE + 7]);                              \
    auto r0 = __builtin_amdgcn_permlane32_swap(a0, b0, false, false); auto r1 = __builtin_amdgcn_permlane32_swap(a1, b1, false, false); \
    u32x4 w = {r0[0], r1[0], r0[1], r1[1]}; OUT = *reinterpret_cast<bf16x8*>(&w); } while (0)
    PK4(p0, 0, pa0); PK4(p0, 8, pa1); PK4(p1, 0, pa2); PK4(p1, 8, pa3);
#undef PK4
}
template <int DQK> __device__ __forceinline__ void qkt(f32x16& p0, f32x16& p1, const char* Ks, const bf16x8* qr, int r32, int hi) {
    p0 = f32x16{}; p1 = f32x16{};
#pragma unroll
    for (int d0 = 0; d0 < DQK / 16; ++d0) { const int cb = (d0 * 16 + hi * 8) * 2;
        const bf16x8 b0 = *reinterpret_cast<const bf16x8*>(Ks + kswz<DQK>(r32, cb));
        const bf16x8 b1 = *reinterpret_cast<const bf16x8*>(Ks + kswz<DQK>(32 + r32, cb));
        p0 = __builtin_amdgcn_mfma_f32_32x32x16_bf16(b0, qr[d0], p0, 0, 0, 0);
        p1 = __builtin_amdgcn_mfma_f32_32x32x16_bf16(b1, qr[d0], p1, 0, 0, 0); }
}
__device__ __forceinline__ int v_st(int k, int c) { const int kk = (k & ~0xC) | ((k & 4) << 1) | ((k & 8) >> 1); return ((kk >> 3) * 4 + (c >> 5)) * 512 + ((kk & 7) * 32 + (c & 31)) * 2; }
__device__ __forceinline__ int v_rd_base(int lane) { return ((lane & 3) << 3) | (((lane >> 2) & 3) << 6) | (((lane >> 4) & 1) << 5) | (((lane >> 5) & 1) << 8); }
constexpr int v_rd_off(int d0, int ks, int half) { return d0 * 512 + ks * 4096 + half * 2048; }
template <int OFF> __device__ __forceinline__ s16x4 tr_read(int vb) {
    s16x4 r; asm volatile("ds_read_b64_tr_b16 %0, %1 offset:%2" : "=&v"(r) : "v"(vb), "i"(OFF) : "memory"); return r;
}
template <int D0> __device__ __forceinline__ void pv_one(f32x16& od, int vb, bf16x8 pa0, bf16x8 pa1, bf16x8 pa2, bf16x8 pa3) {
    const s16x4 l0 = tr_read<v_rd_off(D0, 0, 0)>(vb), h0 = tr_read<v_rd_off(D0, 0, 1)>(vb), l1 = tr_read<v_rd_off(D0, 1, 0)>(vb), h1 = tr_read<v_rd_off(D0, 1, 1)>(vb);
    const s16x4 l2 = tr_read<v_rd_off(D0, 2, 0)>(vb), h2 = tr_read<v_rd_off(D0, 2, 1)>(vb), l3 = tr_read<v_rd_off(D0, 3, 0)>(vb), h3 = tr_read<v_rd_off(D0, 3, 1)>(vb);
    asm volatile("s_waitcnt lgkmcnt(0)" ::: "memory"); SBAR();
#define PK(L, H) (bf16x8){L[0], L[1], L[2], L[3], H[0], H[1], H[2], H[3]}
    od = __builtin_amdgcn_mfma_f32_32x32x16_bf16(pa0, PK(l0, h0), od, 0, 0, 0);
    od = __builtin_amdgcn_mfma_f32_32x32x16_bf16(pa1, PK(l1, h1), od, 0, 0, 0);
    od = __builtin_amdgcn_mfma_f32_32x32x16_bf16(pa2, PK(l2, h2), od, 0, 0, 0);
    od = __builtin_amdgcn_mfma_f32_32x32x16_bf16(pa3, PK(l3, h3), od, 0, 0, 0);
#undef PK
}
__device__ __forceinline__ void pv_d0(f32x16* o, int vb, bf16x8 pa0, bf16x8 pa1, bf16x8 pa2, bf16x8 pa3) {
    pv_one<0>(o[0], vb, pa0, pa1, pa2, pa3); pv_one<1>(o[1], vb, pa0, pa1, pa2, pa3); pv_one<2>(o[2], vb, pa0, pa1, pa2, pa3); pv_one<3>(o[3], vb, pa0, pa1, pa2, pa3);
}

constexpr int SHM_V = 16384, SHM_K64 = 8192, DA_LDS = 2 * SHM_V + 2 * SHM_K64 + 8 * 256;
__device__ __forceinline__ void diff_pass(const bf16_t* __restrict__ Qb, const bf16_t* __restrict__ Kh, const bf16_t* __restrict__ Vh, int seq, char* lds, f32x16 (&o)[4]) {
    int tid_ = threadIdx.x; asm volatile("" : "+v"(tid_));
    const int tid = tid_, wid = tid >> 6, lane = tid & 63, r32 = lane & 31, hi = lane >> 5;
    char* V_lds = lds; char* K_lds = lds + 2 * SHM_V;
    float* ws = (float*)(lds + 2 * SHM_V + 2 * SHM_K64) + wid * 64; float* li_l = ws; float* al_l = ws + 32;
    float m_reg = -1e30f, l_reg = 0;
#pragma unroll
    for (int d = 0; d < 4; ++d) o[d] = f32x16{};
    bf16x8 qr[4];
    const bf16_t* Qw = Qb + (size_t)(wid * 32 + r32) * DM + hi * 8;
#pragma unroll
    for (int d0 = 0; d0 < 4; ++d0) qr[d0] = *reinterpret_cast<const bf16x8*>(Qw + d0 * 16);
    const int sr = tid >> 4, sc = (tid & 15) * 8, vst0 = v_st(sr, sc), vst1 = v_st(32 + sr, sc);
    const int kr = tid >> 3, kc = (tid & 7) * 8, kst = kswz<64>(kr, kc * 2);
    const int vb0 = (int)(uintptr_t)V_lds + v_rd_base(lane);
    struct { bf16x8 vs0, vs1, ks; } sr_[2];
#define SLOAD(i, k0) do { sr_[i].vs0 = *reinterpret_cast<const bf16x8*>(&Vh[(size_t)((k0) + sr) * DM + sc]); sr_[i].vs1 = *reinterpret_cast<const bf16x8*>(&Vh[(size_t)((k0) + 32 + sr) * DM + sc]); \
    sr_[i].ks = *reinterpret_cast<const bf16x8*>(&Kh[(size_t)((k0) + kr) * DM + kc]); } while (0)
#define SWRITE(b, i) do { *(bf16x8*)(V_lds + (b) * SHM_V + vst0) = sr_[i].vs0; *(bf16x8*)(V_lds + (b) * SHM_V + vst1) = sr_[i].vs1; \
    *(bf16x8*)(K_lds + (b) * SHM_K64 + kst) = sr_[i].ks; } while (0)
#define SWAIT() asm volatile("s_waitcnt vmcnt(3)" ::: "memory")
#define RESC(a) do { if (__any((a) < 1.f)) { if (hi == 0) al_l[r32] = (a); asm volatile("s_waitcnt lgkmcnt(0)" ::: "memory"); \
    _Pragma("unroll") for (int d = 0; d < 4; ++d) _Pragma("unroll") for (int r = 0; r < 16; ++r) o[d][r] *= al_l[crow(r, hi)]; } } while (0)
    f32x16 pA0, pA1, pB0, pB1; float mnA, mnB, alA, alB; bf16x8 pa0, pa1, pa2, pa3; const int NT = seq / 64;
    __syncthreads();
    SLOAD(0, 0); asm volatile("s_waitcnt vmcnt(0)" ::: "memory"); SWRITE(0, 0); __syncthreads();
    qkt<64>(pA0, pA1, K_lds, qr, r32, hi); partialSM(pA0, pA1, m_reg, mnA, alA);
    SLOAD(1, 64); if (2 < NT) SLOAD(0, 128);
    SWAIT(); SWRITE(1, 1); __syncthreads();
    for (int j = 1; j + 1 < NT; j += 2) {
        SBAR(); qkt<64>(pB0, pB1, K_lds + SHM_K64, qr, r32, hi);
        finishSM(pA0, pA1, alA, l_reg, pa0, pa1, pa2, pa3); SBAR();
        SLOAD(1, (j + 2) * 64); SBAR();
        pv_d0(o, vb0, pa0, pa1, pa2, pa3); partialSM(pB0, pB1, m_reg, mnB, alB);
        __syncthreads(); SWAIT(); SWRITE(0, 0);
        RESC(alB); __syncthreads();
        SBAR(); qkt<64>(pA0, pA1, K_lds, qr, r32, hi);
        finishSM(pB0, pB1, alB, l_reg, pa0, pa1, pa2, pa3); SBAR();
        if (j + 3 < NT) SLOAD(0, (j + 3) * 64); SBAR();
        pv_d0(o, vb0 + SHM_V, pa0, pa1, pa2, pa3); partialSM(pA0, pA1, m_reg, mnA, alA);
        __syncthreads(); SWAIT(); SWRITE(1, 1);
        RESC(alA); __syncthreads();
    }
    SBAR(); qkt<64>(pB0, pB1, K_lds + SHM_K64, qr, r32, hi);
    finishSM(pA0, pA1, alA, l_reg, pa0, pa1, pa2, pa3); SBAR();
    pv_d0(o, vb0, pa0, pa1, pa2, pa3); partialSM(pB0, pB1, m_reg, mnB, alB);
    __syncthreads(); RESC(alB);
    finishSM(pB0, pB1, alB, l_reg, pa0, pa1, pa2, pa3); SBAR();
    pv_d0(o, vb0 + SHM_V, pa0, pa1, pa2, pa3);
    if (hi == 0) li_l[r32] = l_reg; asm volatile("s_waitcnt lgkmcnt(0)" ::: "memory");
#pragma unroll
    for (int r = 0; r < 16; ++r) { const float rl = __builtin_amdgcn_rcpf(li_l[crow(r, hi)]);
#pragma unroll
        for (int d = 0; d < 4; ++d) o[d][r] *= rl; }
#undef SLOAD
#undef SWRITE
#undef SWAIT
#undef RESC
}

__device__ __forceinline__ void diff_unit(int b, int h, int qb, const bf16_t* Q, const bf16_t* K, const bf16_t* V, bf16_t* YA, float lam, float omli, const float* subln, char* lds) {
    int tid_ = threadIdx.x; asm volatile("" : "+v"(tid_));
    const int tid = tid_, wid = tid >> 6, lane = tid & 63, r32 = lane & 31, hi = lane >> 5;
    const size_t rowbase = (size_t)b * SEQ; const int q0 = qb * 256;
    const bf16_t* Qb = Q + (rowbase + q0) * DM + h * 128;
    const bf16_t* Kh = K + rowbase * DM + h * 128;
    const bf16_t* Vh = V + rowbase * DM + h * 128;
    f32x16 o[4];
    diff_pass(Qb, Kh, Vh, SEQ, lds, o);
    unsigned* park = (unsigned*)(lds + DA_LDS) + wid * 2048 + lane;
#pragma unroll
    for (int d = 0; d < 4; ++d)
#pragma unroll
        for (int r = 0; r < 8; ++r) park[(d * 8 + r) * 64] = cvt_pk_bf16(o[d][2 * r], o[d][2 * r + 1]);
    diff_pass(Qb + 64, Kh + 64, Vh, SEQ, lds, o);
    asm volatile("s_waitcnt lgkmcnt(0)" ::: "memory");
    float ss[16];
#pragma unroll
    for (int r = 0; r < 16; ++r) { float s = 0.f;
#pragma unroll
        for (int d = 0; d < 4; ++d) { const unsigned pw = park[(d * 8 + (r >> 1)) * 64]; const float a = (r & 1) ? bf_hi(pw) : bf_lo(pw); const float v = a - lam * o[d][r]; o[d][r] = v; s += v * v; }
        ss[r] = s; }
#pragma unroll
    for (int r = 0; r < 16; ++r) {
        ss[r] = sum32(ss[r]);
        ss[r] = omli / sqrtf(ss[r] * (1.0f / 128.0f) + EPS); }
    float gl[4];
#pragma unroll
    for (int d = 0; d < 4; ++d) gl[d] = subln[32 * d + r32];
    bf16_t* Ow = YA + (rowbase + q0 + wid * 32) * DM + h * 128 + r32;
#pragma unroll
    for (int r = 0; r < 16; ++r) { const int orow = crow(r, hi);
#pragma unroll
        for (int d = 0; d < 4; ++d) Ow[(size_t)orow * DM + 32 * d] = (bf16_t)(cvt_pk_bf16(o[d][r] * ss[r] * gl[d], 0.f) & 0xffffu); }
}

constexpr int CA_LDS = 32768 + 32768 + 8 * 256;
__device__ __forceinline__ void cross_unit(int b, int hd, int qb, const bf16_t* QC, const bf16_t* KV, bf16_t* OC, char* lds) {
    int tid_ = threadIdx.x; asm volatile("" : "+v"(tid_));
    const int tid = tid_, wid = tid >> 6, lane = tid & 63, r32 = lane & 31, hi = lane >> 5, vimg = wid >> 2;
    char* K_lds = lds; char* V_lds = lds + 32768; float* ws = (float*)(lds + 65536) + wid * 64; float* li_l = ws; float* al_l = ws + 32;
    const size_t qrow = (size_t)b * SEQ + qb * 128 + (wid & 3) * 32;
    const bf16_t* Qw = QC + (qrow + r32) * DM + hd * 256 + hi * 8;
    bf16x8 qr[16];
#pragma unroll
    for (int d0 = 0; d0 < 16; ++d0) qr[d0] = *reinterpret_cast<const bf16x8*>(Qw + d0 * 16);
    const bf16_t* Kh = KV + (size_t)(b * NMEM) * 2048 + hd * 256; const bf16_t* Vh = Kh + 1024;
    const int kr = tid >> 3, kc8 = tid & 7, sr = tid >> 4, sc = (tid & 15) * 8, vst0 = v_st(sr, sc), vst1 = v_st(32 + sr, sc);
    const int vb0 = (int)(uintptr_t)V_lds + vimg * SHM_V + v_rd_base(lane);
    float m_reg = -1e30f, l_reg = 0; f32x16 o[4];
#pragma unroll
    for (int d = 0; d < 4; ++d) o[d] = f32x16{};
    for (int t = 0; t < 4; ++t) {
        const int k0 = t * 64;
        __syncthreads();
        { bf16x8 kk[4];
#pragma unroll
          for (int j = 0; j < 4; ++j) kk[j] = *reinterpret_cast<const bf16x8*>(&Kh[(size_t)(k0 + kr) * 2048 + (kc8 + 8 * j) * 8]);
#pragma unroll
          for (int j = 0; j < 4; ++j) *(bf16x8*)(K_lds + kswz<256>(kr, (kc8 + 8 * j) * 16)) = kk[j]; }
        asm volatile("" ::: "memory");
        { bf16x8 vv[4];
          vv[0] = *reinterpret_cast<const bf16x8*>(&Vh[(size_t)(k0 + sr) * 2048 + sc]);       vv[1] = *reinterpret_cast<const bf16x8*>(&Vh[(size_t)(k0 + 32 + sr) * 2048 + sc]);
          vv[2] = *reinterpret_cast<const bf16x8*>(&Vh[(size_t)(k0 + sr) * 2048 + 128 + sc]); vv[3] = *reinterpret_cast<const bf16x8*>(&Vh[(size_t)(k0 + 32 + sr) * 2048 + 128 + sc]);
          *(bf16x8*)(V_lds + vst0) = vv[0]; *(bf16x8*)(V_lds + vst1) = vv[1]; *(bf16x8*)(V_lds + SHM_V + vst0) = vv[2]; *(bf16x8*)(V_lds + SHM_V + vst1) = vv[3]; }
        __syncthreads();
        f32x16 p0, p1; float mn, al; bf16x8 pa0, pa1, pa2, pa3;
        qkt<256>(p0, p1, K_lds, qr, r32, hi); partialSM(p0, p1, m_reg, mn, al);
        if (__any(al < 1.f)) { if (hi == 0) al_l[r32] = al; asm volatile("s_waitcnt lgkmcnt(0)" ::: "memory");
#pragma unroll
            for (int d = 0; d < 4; ++d)
#pragma unroll
                for (int r = 0; r < 16; ++r) o[d][r] *= al_l[crow(r, hi)]; }
        finishSM(p0, p1, al, l_reg, pa0, pa1, pa2, pa3); SBAR();
        pv_d0(o, vb0, pa0, pa1, pa2, pa3);
    }
    if (hi == 0) li_l[r32] = l_reg; asm volatile("s_waitcnt lgkmcnt(0)" ::: "memory");
    bf16_t* Ow = OC + qrow * DM + hd * 256 + vimg * 128 + r32;
#pragma unroll
    for (int r = 0; r < 16; ++r) { const float rl = __builtin_amdgcn_rcpf(li_l[crow(r, hi)]); const int orow = crow(r, hi);
#pragma unroll
        for (int d = 0; d < 4; ++d) Ow[(size_t)orow * DM + 32 * d] = (bf16_t)(cvt_pk_bf16(o[d][r] * rl, 0.f) & 0xffffu); }
    __syncthreads();
}
#undef SBAR
}

__device__ __forceinline__ f32x4 ld_bf4(const bf16_t* p) { const u32x2 w = *(const u32x2*)p; return (f32x4){bf_lo(w.x), bf_hi(w.x), bf_lo(w.y), bf_hi(w.y)}; }
__device__ __forceinline__ void st_bf4(bf16_t* p, f32x4 v) { u32x2 w; w.x = cvt_pk_bf16(v[0], v[1]); w.y = cvt_pk_bf16(v[2], v[3]); *(u32x2*)p = w; }
__device__ __forceinline__ void ld_bf8(const bf16_t* p, f32x4& a, f32x4& b) { const u32x4 w = *(const u32x4*)p; a = (f32x4){bf_lo(w.x), bf_hi(w.x), bf_lo(w.y), bf_hi(w.y)}; b = (f32x4){bf_lo(w.z), bf_hi(w.z), bf_lo(w.w), bf_hi(w.w)}; }

__device__ __forceinline__ void conv_rows(const bf16_t* U, const bf16_t* CB, const float* cw, bf16_t* YC, int gw, int NGW, int lane) {
    for (int g = gw; g < T / 8; g += NGW) { const int t0 = g * 8;
#pragma unroll
        for (int c2 = 0; c2 < 2; ++c2) { const int col = c2 * 512 + lane * 8;
            f32x4 w0a = *(const f32x4*)(cw + col), w0b = *(const f32x4*)(cw + col + 4), w1a = *(const f32x4*)(cw + DM + col), w1b = *(const f32x4*)(cw + DM + col + 4),
                  w2a = *(const f32x4*)(cw + 2 * DM + col), w2b = *(const f32x4*)(cw + 2 * DM + col + 4);
            f32x4 pa = {0.f, 0.f, 0.f, 0.f}, pb = pa, ca, cb_, na, nb;
            if ((t0 & (SEQ - 1)) != 0) ld_bf8(U + (size_t)(t0 - 1) * DM + col, pa, pb);
            ld_bf8(U + (size_t)t0 * DM + col, ca, cb_);
            for (int i = 0; i < 8; ++i) { const int t = t0 + i;
                if (((t + 1) & (SEQ - 1)) != 0) ld_bf8(U + (size_t)(t + 1) * DM + col, na, nb); else { na = (f32x4){0.f, 0.f, 0.f, 0.f}; nb = na; }
                f32x4 ga, gb; ld_bf8(CB + (size_t)t * DM + col, ga, gb);
                st8(YC + (size_t)t * DM + col, ga * (w0a * pa + w1a * ca + w2a * na), gb * (w0b * pb + w1b * cb_ + w2b * nb));
                pa = ca; pb = cb_; ca = na; cb_ = nb; } } }
}
__device__ __forceinline__ void x0_row(const float* xrow, bf16_t* xbrow, float* prow, int lane) {
    const f32x4* xr = (const f32x4*)xrow + lane; float s = 0.f;
#pragma unroll
    for (int j = 0; j < 4; ++j) { const f32x4 v = xr[64 * j]; s += (v[0] * v[0] + v[1] * v[1]) + (v[2] * v[2] + v[3] * v[3]); st_bf4(xbrow + j * 256 + lane * 4, v); }
    s = wave_sum(s);
    if (lane < 16) prow[lane] = lane == 0 ? s : 0.f;
}
__device__ __forceinline__ void memn_row(const float* xrow, const float* g, bf16_t* orow, int lane) {
    const f32x4* xr = (const f32x4*)xrow + lane; const f32x4* gr = (const f32x4*)g + lane; f32x4 v[4]; float s = 0.f;
#pragma unroll
    for (int j = 0; j < 4; ++j) { v[j] = xr[64 * j]; s += (v[j][0] * v[j][0] + v[j][1] * v[j][1]) + (v[j][2] * v[j][2] + v[j][3] * v[j][3]); }
    const float r = 1.0f / sqrtf(wave_sum(s) * (1.0f / DM) + EPS);
#pragma unroll
    for (int j = 0; j < 4; ++j) st_bf4(orow + j * 256 + lane * 4, v[j] * r * gr[64 * j]);
}
__device__ __forceinline__ void combine_row(int t, const LAS int* bst, const int* tok_e, const int* tok_pos, const float* tok_w, const bf16_t* Y, const float* xi, float* xio, bf16_t* xb, float* part, const float* gfin, bool last, int lane) {
    const int e0 = tok_e[2 * t], e1 = tok_e[2 * t + 1]; const float w0 = tok_w[2 * t], w1 = tok_w[2 * t + 1];
    const size_t s0 = (size_t)bst[e0] * 256 + tok_pos[2 * t], s1 = (size_t)bst[e1] * 256 + tok_pos[2 * t + 1];
    f32x4 v[4]; float s = 0.f;
#pragma unroll
    for (int j = 0; j < 4; ++j) { const int c = j * 256 + lane * 4;
        v[j] = *(const f32x4*)(xi + (size_t)t * DM + c) + w0 * ld_bf4(Y + s0 * DM + c) + w1 * ld_bf4(Y + s1 * DM + c);
        s += (v[j][0] * v[j][0] + v[j][1] * v[j][1]) + (v[j][2] * v[j][2] + v[j][3] * v[j][3]); }
    s = wave_sum(s);
    if (!last) {
#pragma unroll
        for (int j = 0; j < 4; ++j) { const int c = j * 256 + lane * 4; *(f32x4*)(xio + (size_t)t * DM + c) = v[j]; st_bf4(xb + (size_t)t * DM + c, v[j]); }
        if (lane < 16) part[(size_t)t * 16 + lane] = lane == 0 ? s : 0.f;
    } else {
        const float r = 1.0f / sqrtf(s * (1.0f / DM) + EPS);
#pragma unroll
        for (int j = 0; j < 4; ++j) { const int c = j * 256 + lane * 4; *(f32x4*)(xio + (size_t)t * DM + c) = v[j] * r * *(const f32x4*)(gfin + c); }
    }
}
__device__ __forceinline__ void route_token(int t, const float* x, const float* part, const float (&gf)[16], const f32x4 (&wg)[16], const LAS char* WeL,
                                            unsigned* ecnt, int* elist, int* tok_e, int* tok_pos, float* tok_w, int lane) {
    float pp = lane < 16 ? part[(size_t)t * 16 + lane] : 0.f; pp = wave_sum(pp);
    const float rs = 1.0f / sqrtf(pp * (1.0f / DM) + EPS);
    float hv[16]; f32x4 ag = {0.f, 0.f, 0.f, 0.f};
#pragma unroll
    for (int j = 0; j < 16; ++j) { hv[j] = x[(size_t)t * DM + j * 64 + lane] * rs * gf[j]; ag += hv[j] * wg[j]; }
    float a0 = wave_sum(ag[0]), a1 = wave_sum(ag[1]), a2 = wave_sum(ag[2]), a3 = wave_sum(ag[3]);
    int gi = 0; float am = a0; if (a1 > am) { am = a1; gi = 1; } if (a2 > am) { am = a2; gi = 2; } if (a3 > am) { am = a3; gi = 3; }
    const float gw_ = 1.0f / (__expf(a0 - am) + __expf(a1 - am) + __expf(a2 - am) + __expf(a3 - am));
    gi = __builtin_amdgcn_readfirstlane(gi);
    f32x4 ea = {0.f, 0.f, 0.f, 0.f}, eb = ea;
#pragma unroll
    for (int j = 0; j < 16; ++j) { const int k = j * 64 + lane; const int sw = (k >> 1) & 7;
        const f32x4 wa = *(const LAS f32x4*)(WeL + k * 128 + (((2 * gi) ^ sw) << 4)), wb = *(const LAS f32x4*)(WeL + k * 128 + (((2 * gi + 1) ^ sw) << 4));
        ea += hv[j] * wa; eb += hv[j] * wb; }
    float e[8];
#pragma unroll
    for (int q = 0; q < 4; ++q) { e[q] = wave_sum(ea[q]); e[4 + q] = wave_sum(eb[q]); }
    int i1 = 0; float e1v = e[0];
#pragma unroll
    for (int q = 1; q < 8; ++q) if (e[q] > e1v) { e1v = e[q]; i1 = q; }
    int i2 = (i1 == 0) ? 1 : 0; float e2v = -3.0e38f;
#pragma unroll
    for (int q = 0; q < 8; ++q) if (q != i1 && e[q] > e2v) { e2v = e[q]; i2 = q; }
    const float z = __expf(e2v - e1v); const float w1 = gw_ / (1.0f + z), w2 = gw_ * z / (1.0f + z);
    if (lane == 0) {
        const int x1 = gi * 8 + i1, x2 = gi * 8 + i2;
        const int p1 = (int)atomicAdd(ecnt + x1 * 64, 1u), p2 = (int)atomicAdd(ecnt + x2 * 64, 1u);
        elist[(size_t)x1 * T + p1] = t; elist[(size_t)x2 * T + p2] = t;
        tok_e[2 * t] = x1; tok_e[2 * t + 1] = x2; tok_pos[2 * t] = p1; tok_pos[2 * t + 1] = p2; tok_w[2 * t] = w1; tok_w[2 * t + 1] = w2;
    }
}

__device__ __forceinline__ int map_row(int mode, int n) {
    if (mode == 1) {
        if (n < 2048) { const int d = n & 63; const int p = (d >= 4 && d < 8) ? d + 4 : (d >= 8 && d < 12) ? d - 4 : d; return (n & ~63) + p; }
        if (n >= 4096 && n < 5120) { const int q = n - 4096; return 4096 + (q >> 7) * 256 + (q & 127); }
        if (n >= 5120 && n < 6144) { const int q = n - 5120; return 4096 + (q >> 7) * 256 + 128 + (q & 127); }
        return n;
    }
    if (mode == 2) return (n >> 7) * 256 + (n & 127);
    if (mode == 3) return (n >> 7) * 256 + 128 + (n & 127);
    return n;
}
__device__ __forceinline__ void transpose_item(const float* W, int ldw, int k0, int n0, const float* gain, bf16_t* WT, int ldt, int mode, LAS float* scr, int lane) {
    f32x4 v[16];
#pragma unroll
    for (int i = 0; i < 16; ++i) v[i] = *(const f32x4*)(W + (size_t)(k0 + 4 * i + (lane >> 4)) * ldw + n0 + (lane & 15) * 4);
    if (gain) {
#pragma unroll
        for (int i = 0; i < 16; ++i) v[i] = v[i] * gain[k0 + 4 * i + (lane >> 4)];
    }
#pragma unroll
    for (int i = 0; i < 16; ++i) { LAS float* s = scr + (4 * i + (lane >> 4)) * 65 + (lane & 15) * 4; s[0] = v[i][0]; s[1] = v[i][1]; s[2] = v[i][2]; s[3] = v[i][3]; }
    LDS_WAIT(); asm volatile("" ::: "memory");
    const int c = lane & 7;
#pragma unroll
    for (int j = 0; j < 8; ++j) { const int n = (lane >> 3) + 8 * j; const LAS float* s = scr + (8 * c) * 65 + n;
        u32x4 o; o.x = cvt_pk_bf16(s[0 * 65], s[1 * 65]); o.y = cvt_pk_bf16(s[2 * 65], s[3 * 65]); o.z = cvt_pk_bf16(s[4 * 65], s[5 * 65]); o.w = cvt_pk_bf16(s[6 * 65], s[7 * 65]);
        *(u32x4*)(WT + (size_t)map_row(mode, n0 + n) * ldt + k0 + 8 * c) = o; }
    LDS_WAIT(); asm volatile("" ::: "memory");
}
constexpr int IT_IN = 2048, IT_BR = 512, IT_SQ = 256, IT_KV = 512, IT_EXP = 576, IT_LAYER = IT_IN + IT_BR + 3 * IT_SQ + IT_KV + 32 * IT_EXP;
__device__ __forceinline__ void rope_entry(int idx, float* cosT, float* sinT) {
    const int t = idx >> 3, i = idx & 7;
    const double inv = i == 0 ? 1.0 : i == 1 ? 0.19392274474868576 : i == 2 ? 0.03760603093086393 : i == 3 ? 0.007292664737217109 : i == 4 ? 0.001414213562373095 : i == 5 ? 0.0002742481756762073 : i == 6 ? 5.318295896944988e-05 : 1.031338537721246e-05;
    const double ang = (double)t * inv;
    const double kq = __builtin_rint(ang * 0.6366197723675814);
    const double r = (ang - kq * 1.5707963267341256) - kq * 6.077100506506192e-11;
    const double r2 = r * r;
    double sn = 1.0 / 6227020800.0; sn = sn * r2 - 1.0 / 39916800.0; sn = sn * r2 + 1.0 / 362880.0; sn = sn * r2 - 1.0 / 5040.0; sn = sn * r2 + 1.0 / 120.0; sn = sn * r2 - 1.0 / 6.0; sn = sn * r2 + 1.0; sn = sn * r;
    double cs = 1.0 / 479001600.0; cs = cs * r2 - 1.0 / 3628800.0; cs = cs * r2 + 1.0 / 40320.0; cs = cs * r2 - 1.0 / 720.0; cs = cs * r2 + 1.0 / 24.0; cs = cs * r2 - 0.5; cs = cs * r2 + 1.0;
    const int q = ((int)kq) & 3;
    const double c = q == 0 ? cs : q == 1 ? -sn : q == 2 ? -cs : sn;
    const double s = q == 0 ? sn : q == 1 ? cs : q == 2 ? -sn : -cs;
    cosT[idx] = (float)c; sinT[idx] = (float)s;
}

#define XB_TMO      128
#define XB_XCNT(j)  (256  + 64 * (j))
#define XB_XSUB(j)  (1280 + 64 * (j))
#define XB_XGEN(j)  (2304 + 64 * (j))
#define XB_TOP      3328
#define XB_TOPGEN   3392
#define XCD_BAR_WORDS 3456
#define XB_SPIN_CAP (1u << 18)
__device__ __forceinline__ unsigned xb_ld(unsigned* p)              { return __hip_atomic_load(p, __ATOMIC_RELAXED, __HIP_MEMORY_SCOPE_AGENT); }
__device__ __forceinline__ unsigned xb_add(unsigned* p, unsigned v) { return __hip_atomic_fetch_add(p, v, __ATOMIC_RELAXED, __HIP_MEMORY_SCOPE_AGENT); }
__device__ __forceinline__ unsigned xb_xcc_id() { return (unsigned)__builtin_amdgcn_s_getreg((3 << 11) | 20) & 0xFu; }
#define XB_SPIN(cond, bar) do { unsigned _sp = 0; while (cond) { __builtin_amdgcn_s_sleep(1); \
    if ((++_sp & 255u) == 0u) { if (xb_ld(&(bar)[XB_TMO])) break; if (_sp > XB_SPIN_CAP) { atomicAdd(&(bar)[XB_TMO], 1u); break; } } } } while (0)
struct XcdBarrier { unsigned* bar; unsigned x; volatile LAS unsigned* st; };
__device__ __forceinline__ XcdBarrier xcd_barrier_post(unsigned* bar, volatile LAS unsigned* st) {
    XcdBarrier b; b.bar = bar; b.x = (unsigned)__builtin_amdgcn_readfirstlane((int)xb_xcc_id()); b.st = st;
    if (threadIdx.x == 0) (void)xb_add(&bar[XB_XCNT(b.x)], 1u);
    return b;
}
__device__ __forceinline__ void xcd_barrier_complete(unsigned* bar, unsigned x, unsigned& nloc, unsigned& nx) {
    const unsigned G = gridDim.x * gridDim.y * gridDim.z;
    unsigned sum, cnt, mine, sp = 0u;
    for (;;) {
        sum = 0u; cnt = 0u; mine = 0u;
#pragma unroll
        for (unsigned j = 0; j < 16; ++j) { const unsigned c = xb_ld(&bar[XB_XCNT(j)]); sum += c; cnt += (c > 0u) ? 1u : 0u; mine = (j == x) ? c : mine; }
        if (sum == G) break;
        __builtin_amdgcn_s_sleep(1);
        if ((++sp & 255u) == 0u) { if (xb_ld(&bar[XB_TMO])) break; if (sp > XB_SPIN_CAP) { atomicAdd(&bar[XB_TMO], 1u); break; } }
    }
    nloc = mine > 0u ? mine : 1u; nx = cnt > 0u ? cnt : 1u;
}
__device__ __forceinline__ void xcd_barrier(const XcdBarrier& b) {
    asm volatile("s_waitcnt vmcnt(0)" ::: "memory");
    __syncthreads();
    int t0_ = threadIdx.x; asm volatile("" : "+v"(t0_));
    if (t0_ == 0) {
        unsigned* bar = b.bar; unsigned bx_ = b.x;
        asm volatile("" : "+s"(bar), "+s"(bx_));
        __builtin_amdgcn_s_waitcnt(0);
        unsigned nloc = b.st[0], nx = b.st[1];
        if (nloc == 0u) { xcd_barrier_complete(bar, bx_, nloc, nx); b.st[0] = nloc; b.st[1] = nx; }
        const unsigned old = xb_add(&bar[XB_XSUB(bx_)], 1u);
        const unsigned gen = old / nloc;
        if (old + 1u == (gen + 1u) * nloc) {
            __builtin_amdgcn_fence(__ATOMIC_RELEASE, "agent");
            asm volatile("s_waitcnt vmcnt(0)" ::: "memory");
            const unsigned og = xb_add(&bar[XB_TOP], 1u);
            const unsigned tg = og / nx;
            if (og + 1u == (tg + 1u) * nx) xb_add(&bar[XB_TOPGEN], 1u);
            else XB_SPIN(xb_ld(&bar[XB_TOPGEN]) == tg, bar);
            __builtin_amdgcn_fence(__ATOMIC_ACQUIRE, "agent");
            xb_add(&bar[XB_XGEN(bx_)], 1u);
            asm volatile("s_waitcnt vmcnt(0)" ::: "memory");
        } else {
            XB_SPIN(xb_ld(&bar[XB_XGEN(bx_)]) == gen, bar);
            __builtin_amdgcn_fence(__ATOMIC_ACQUIRE, "agent");
            asm volatile("s_waitcnt vmcnt(0)" ::: "memory");
        }
    }
    __syncthreads();
}

struct Args { const float* in[24]; float* out; unsigned char* ws; int ph_lo, ph_hi; };
enum { I_X = 0, I_MEM, I_NMIX, I_WIN, I_LQ1, I_LK1, I_LQ2, I_LK2, I_SUBLN, I_CONVW, I_WBR, I_WO, I_NCROSS, I_NMEM, I_WCQ, I_WCKV, I_WCO, I_NFFN, I_WRG, I_WRE, I_WG, I_WU, I_WD, I_NFIN };

__global__ void __launch_bounds__(512, 2) fwd(Args args) {
    extern __shared__ __attribute__((aligned(16))) unsigned char lds_raw[];
    LAS unsigned char* lds = (LAS unsigned char*)lds_raw;
    const int tid = threadIdx.x, lane = tid & 63, wave = __builtin_amdgcn_readfirstlane(tid >> 6);
    const int G = gridDim.x, bx = blockIdx.x, vcu = (G % 8 == 0) ? (bx % 8) * (G / 8) + bx / 8 : bx;
    const int gw0 = vcu * 8 + wave, NGW = G * 8;
    unsigned char* ws = args.ws;
    unsigned* ctl = (unsigned*)(ws + WS_CTL);
    for (int u = tid; u < (LDS_BYTES - LDSCTL_OFF) / 4; u += 512) ((LAS unsigned*)(lds + LDSCTL_OFF))[u] = 0u;
    __syncthreads();
    volatile LAS unsigned* MISC = (volatile LAS unsigned*)(lds + LC_MISC);
    LAS int* bst = (LAS int*)(lds + LC_BST); LAS int* cntL = (LAS int*)(lds + LC_CNT); LAS int* bexp = (LAS int*)(lds + LC_BEXP);
#if MK_SPLIT
    XcdBarrier bar; bar.bar = ctl + CW_BAR; bar.x = 0; bar.st = nullptr;
#define GRID_BAR() do { } while (0)
#else
    XcdBarrier bar = xcd_barrier_post(ctl + CW_BAR, MISC + 8);
#define GRID_BAR() do { xcd_barrier(bar); if ((PROBE_MASK >> 12) & 1) xcd_barrier(bar); } while (0)
#endif
    const int lo = args.ph_lo, hi_ = args.ph_hi; (void)lo; (void)hi_;
#ifndef PH_MASK
#define PH_MASK 0xfff
#endif
#define PEN(j) (((PH_MASK) >> (j)) & 1)
#ifndef PROBE_MASK
#define PROBE_MASK 0
#endif
#define NREP(j) ((((PROBE_MASK) >> (j)) & 1) ? 2 : 1)
#if MK_SPLIT
#define IN(k) (lo <= (k) && (k) < hi_)
#else
#define IN(k) true
#endif
#define OPQ_LANE() int tid_o_ = threadIdx.x, gw_o_ = gw0; asm volatile("" : "+v"(tid_o_), "+s"(gw_o_)); const int tid = tid_o_, lane = tid_o_ & 63, gw = gw_o_; (void)tid; (void)lane; (void)gw
#define SEAM(k) do { if (IN(k) && IN((k) + 1)) GRID_BAR(); } while (0)
    float* cosT = (float*)(ws + WS_ROPE); float* sinT = cosT + SEQ * 8;
    float* part = (float*)(ws + WS_PART);
    int* tok_e = (int*)(ws + WS_TOK); int* tok_pos = tok_e + 2 * T; float* tok_w = (float*)(tok_pos + 2 * T);
    int* elist = (int*)(ws + WS_ELIST);
    bf16_t* memn = (bf16_t*)(ws + WS_MEMN); bf16_t* KVC = (bf16_t*)(ws + WS_KVC); bf16_t* XB = (bf16_t*)(ws + WS_XB);
    bf16_t* Qb = (bf16_t*)(ws + WS_Q); bf16_t* Kb = (bf16_t*)(ws + WS_K); bf16_t* Vb = (bf16_t*)(ws + WS_V); bf16_t* Ub = (bf16_t*)(ws + WS_U); bf16_t* CBb = (bf16_t*)(ws + WS_CB);
    bf16_t* Gb = (bf16_t*)(ws + WS_G); bf16_t* YA = (bf16_t*)(ws + WS_YA); bf16_t* YC = (bf16_t*)(ws + WS_YC); bf16_t* Mb = (bf16_t*)(ws + WS_M);
    bf16_t* QC = (bf16_t*)(ws + WS_QC); bf16_t* OC = (bf16_t*)(ws + WS_OC); bf16_t* ACT = (bf16_t*)(ws + WS_ACT); bf16_t* Yb = (bf16_t*)(ws + WS_Y);
    float* xs = args.out;

    for (int rep_ = 0; rep_ < NREP(11); ++rep_) { if (IN(0) && PEN(11)) {
        OPQ_LANE();
        LAS float* scr = (LAS float*)(lds + wave * 16640);
        for (int it = gw; it < NL * IT_LAYER; it += NGW) {
            const int l = it / IT_LAYER; int r = it - l * IT_LAYER; unsigned char* wl = ws + WS_W + (size_t)l * WL_SZ;
            if (r < IT_IN) { transpose_item(args.in[I_WIN] + (size_t)l * DM * INW, INW, (r >> 7) * 64, (r & 127) * 64, args.in[I_NMIX] + l * DM, (bf16_t*)(wl + WL_IN), DM, 1, scr, lane); continue; } r -= IT_IN;
            if (r < IT_BR) { const int n = r >> 8, q = r & 255; transpose_item(args.in[I_WBR] + (size_t)(l * 2 + n) * DM * DM, DM, (q >> 4) * 64, (q & 15) * 64, nullptr, (bf16_t*)(wl + WL_BR) + (size_t)n * DM * DM, DM, 0, scr, lane); continue; } r -= IT_BR;
            if (r < IT_SQ) { transpose_item(args.in[I_WO] + (size_t)l * DM * DM, DM, (r >> 4) * 64, (r & 15) * 64, nullptr, (bf16_t*)(wl + WL_O), DM, 0, scr, lane); continue; } r -= IT_SQ;
            if (r < IT_SQ) { transpose_item(args.in[I_WCQ] + (size_t)l * DM * DM, DM, (r >> 4) * 64, (r & 15) * 64, args.in[I_NCROSS] + l * DM, (bf16_t*)(wl + WL_CQ), DM, 0, scr, lane); continue; } r -= IT_SQ;
            if (r < IT_KV) { transpose_item(args.in[I_WCKV] + (size_t)l * DM * 2048, 2048, (r >> 5) * 64, (r & 31) * 64, nullptr, (bf16_t*)(wl + WL_CKV), DM, 0, scr, lane); continue; } r -= IT_KV;
            if (r < IT_SQ) { transpose_item(args.in[I_WCO] + (size_t)l * DM * DM, DM, (r >> 4) * 64, (r & 15) * 64, nullptr, (bf16_t*)(wl + WL_CO), DM, 0, scr, lane); continue; } r -= IT_SQ;
            const int e = r / IT_EXP, r3 = r - e * IT_EXP, ty = r3 / 192, r4 = r3 - ty * 192;
            if (ty < 2) transpose_item(args.in[ty == 0 ? I_WG : I_WU] + (size_t)(l * NE + e) * DM * DE, DE, (r4 / 12) * 64, (r4 % 12) * 64, args.in[I_NFFN] + l * DM, (bf16_t*)(wl + WL_GU) + (size_t)e * 1536 * DM, DM, 2 + ty, scr, lane);
            else transpose_item(args.in[I_WD] + (size_t)(l * NE + e) * DE * DM, DM, (r4 >> 4) * 64, (r4 & 15) * 64, nullptr, (bf16_t*)(wl + WL_DN) + (size_t)e * DM * DE, DE, 0, scr, lane);
        }
        for (int m = gw; m < MT; m += NGW) memn_row(args.in[I_MEM] + (size_t)m * DM, args.in[I_NMEM], memn + (size_t)m * DM, lane);
        for (int m = gw; m < T; m += NGW) x0_row(args.in[I_X] + (size_t)m * DM, XB + (size_t)m * DM, part + (size_t)m * 16, lane);
        for (int i = vcu * 512 + tid; i < SEQ * 8; i += G * 512) rope_entry(i, cosT, sinT);
    } if (rep_ + 1 < NREP(11)) GRID_BAR(); }
    SEAM(0);

    for (int l = 0; l < NL; ++l) {
        const int pb = 1 + NPH_L * l;
        unsigned char* wl = ws + WS_W + (size_t)l * WL_SZ;
        const float* xin = (l == 0) ? args.in[I_X] : xs;
        unsigned* ecnt = ctl + CW_ECNT + l * 32 * 64;
        for (int rep_ = 0; rep_ < NREP(0); ++rep_) { if (IN(pb + 0) && PEN(0)) {
            { DenseSched S; S.init(XB, wl + WL_IN, T, INW, DM, DM, G, bx);
              EpiIn E{part, cosT, sinT, Qb, Kb, Vb, Ub, CBb, Gb};
              pg8::gemm_phase<EpiIn, DenseSched, false, true>(lds, DM, DM, S, E); }
            if (l == 0) { KvcSched S{(const char*)memn, (const char*)(ws + WS_W + WL_CKV), G, bx};
              EpiPlain E{KVC, 2048, nullptr, 1.0f, (size_t)MT * 2048};
              pg8::gemm_phase<EpiPlain, KvcSched, false, true>(lds, DM, DM, S, E); }
        } if (rep_ + 1 < NREP(0)) GRID_BAR(); }
        SEAM(pb + 0);
        for (int rep_ = 0; rep_ < NREP(1); ++rep_) { if (IN(pb + 1) && PEN(1)) {
            OPQ_LANE();
            conv_rows(Ub, CBb, args.in[I_CONVW] + (size_t)l * 3 * DM, YC, gw, NGW, lane);
            const float s1 = wave_sum(args.in[I_LQ1][l * 64 + lane] * args.in[I_LK1][l * 64 + lane]), s2 = wave_sum(args.in[I_LQ2][l * 64 + lane] * args.in[I_LK2][l * 64 + lane]);
            const float li = lambda_init(l), lam = expf(s1) - expf(s2) + li;
            for (int u = vcu; u < NB * NHD * 8; u += G) { const int bh = u >> 3, qb = u & 7;
                att::diff_unit(bh >> 3, bh & 7, qb, Qb, Kb, Vb, YA, lam, 1.0f - li, args.in[I_SUBLN] + l * 128, (char*)lds_raw); }
            __syncthreads();
        } if (rep_ + 1 < NREP(1)) GRID_BAR(); }
        SEAM(pb + 1);
        for (int rep_ = 0; rep_ < NREP(2); ++rep_) { if (IN(pb + 2) && PEN(2)) {
            BrSched S; S.d.init(YA, wl + WL_BR, T, DM, DM, DM, G, bx); S.A1 = (const char*)YC; S.B1 = (const char*)(wl + WL_BR) + (size_t)DM * DM * 2;
            EpiBr E{Gb, Mb};
            pg8::gemm_phase<EpiBr, BrSched, false, true>(lds, DM, DM, S, E);
        } if (rep_ + 1 < NREP(2)) GRID_BAR(); }
        SEAM(pb + 2);
        for (int rep_ = NREP(3) - 1; rep_ >= 0; --rep_) { if (IN(pb + 3) && PEN(3)) {
            DenseSched S; S.init(Mb, wl + WL_O, T, DM, DM, DM, G, bx);
            EpiRes E{xin, rep_ ? (float*)(ws + WS_DUMMY) : xs, rep_ ? (bf16_t*)(ws + WS_DUMMY + 64 * MiB) : XB, rep_ ? (float*)(ws + WS_DUMMY + 96 * MiB) : part};
            pg8::gemm_phase<EpiRes, DenseSched, false, true>(lds, DM, DM, S, E);
        } if (rep_) GRID_BAR(); }
        SEAM(pb + 3);
        for (int rep_ = 0; rep_ < NREP(4); ++rep_) { if (IN(pb + 4) && PEN(4)) {
            DenseSched S; S.init(XB, wl + WL_CQ, T, DM, DM, DM, G, bx);
            EpiPlain E{QC, DM, part, CQSCALE, 0};
            pg8::gemm_phase<EpiPlain, DenseSched, false, true>(lds, DM, DM, S, E);
        } if (rep_ + 1 < NREP(4)) GRID_BAR(); }
        SEAM(pb + 4);
        for (int rep_ = 0; rep_ < NREP(5); ++rep_) { if (IN(pb + 5) && PEN(5)) {
            for (int u = vcu; u < NB * 4 * 16; u += G) { const int bh = u >> 4, qb = u & 15;
                att::cross_unit(bh >> 2, bh & 3, qb, QC, KVC + (size_t)l * MT * 2048, OC, (char*)lds_raw); }
        } if (rep_ + 1 < NREP(5)) GRID_BAR(); }
        SEAM(pb + 5);
        for (int rep_ = NREP(6) - 1; rep_ >= 0; --rep_) { if (IN(pb + 6) && PEN(6)) {
            DenseSched S; S.init(OC, wl + WL_CO, T, DM, DM, DM, G, bx);
            EpiRes E{xs, rep_ ? (float*)(ws + WS_DUMMY) : xs, rep_ ? (bf16_t*)(ws + WS_DUMMY + 64 * MiB) : XB, rep_ ? (float*)(ws + WS_DUMMY + 96 * MiB) : part};
            pg8::gemm_phase<EpiRes, DenseSched, false, true>(lds, DM, DM, S, E);
        } if (rep_) GRID_BAR(); }
        SEAM(pb + 6);
        if (IN(pb + 7) && PEN(7)) {
            OPQ_LANE();
            const float* We = args.in[I_WRE] + (size_t)l * DM * NE;
            for (int i = tid; i < DM * 8; i += 512) { const int k = i >> 3, c = i & 7; *(LAS f32x4*)(lds + k * 128 + ((c ^ ((k >> 1) & 7)) << 4)) = *(const f32x4*)(We + k * 32 + c * 4); }
            float gf[16]; f32x4 wg[16];
#pragma unroll
            for (int j = 0; j < 16; ++j) { gf[j] = args.in[I_NFFN][l * DM + j * 64 + lane]; wg[j] = *(const f32x4*)(args.in[I_WRG] + (size_t)l * DM * 4 + (j * 64 + lane) * 4); }
            __syncthreads();
            for (int rep_ = NREP(7) - 1; rep_ >= 0; --rep_) {
                int* dmy = (int*)(ws + WS_DUMMY + 97 * MiB);
                for (int t = gw; t < T; t += NGW) route_token(t, xs, part, gf, wg, (const LAS char*)lds, rep_ ? ecnt + 4 * 32 * 64 : ecnt, rep_ ? dmy : elist, rep_ ? dmy + 32 * T : tok_e, rep_ ? dmy + 34 * T : tok_pos, rep_ ? (float*)(dmy + 36 * T) : tok_w, lane);
                if (rep_) GRID_BAR(); }
            __syncthreads();
        }
        SEAM(pb + 7);
        if (IN(pb + 8) || IN(pb + 9) || IN(pb + 10)) {
            OPQ_LANE();
            if (tid < 32) cntL[tid] = (int)__hip_atomic_load(ecnt + tid * 64, __ATOMIC_RELAXED, __HIP_MEMORY_SCOPE_AGENT);
            __syncthreads();
            if (tid == 0) { int a = 0;
#pragma unroll 1
                for (int e = 0; e < 32; ++e) { bst[e] = a; const int nb = (cntL[e] + 255) >> 8;
#pragma unroll 1
                    for (int q = 0; q < nb; ++q) bexp[a + q] = e;
                    a += nb; }
                bst[32] = a; }
            __syncthreads();
        }
        for (int rep_ = 0; rep_ < NREP(8); ++rep_) { if (IN(pb + 8) && PEN(8)) {
            MoeSched S{bst, cntL, bexp, (const char*)XB, (const char*)(wl + WL_GU), elist, (size_t)1536 * DM * 2, (size_t)256 * DM * 2, 6, G, vcu, true};
            EpiGU E{part, ACT};
            pg8::gemm_phase<EpiGU, MoeSched, true, true>(lds, DM, DM, S, E);
        } if (rep_ + 1 < NREP(8)) GRID_BAR(); }
        SEAM(pb + 8);
        for (int rep_ = 0; rep_ < NREP(9); ++rep_) { if (IN(pb + 9) && PEN(9)) {
            MoeSched S{bst, cntL, bexp, (const char*)ACT, (const char*)(wl + WL_DN), elist, (size_t)DM * DE * 2, (size_t)256 * DE * 2, 4, G, vcu, false};
            EpiPlain E{Yb, DM, nullptr, 1.0f, 0};
            pg8::gemm_phase<EpiPlain, MoeSched, false, true>(lds, DE, DE, S, E);
        } if (rep_ + 1 < NREP(9)) GRID_BAR(); }
        SEAM(pb + 9);
        if (IN(pb + 10) && PEN(10)) {
            OPQ_LANE();
            for (int rep_ = NREP(10) - 1; rep_ >= 0; --rep_) {
                for (int t = gw; t < T; t += NGW) combine_row(t, bst, tok_e, tok_pos, tok_w, Yb, xs, rep_ ? (float*)(ws + WS_DUMMY) : xs, rep_ ? (bf16_t*)(ws + WS_DUMMY + 64 * MiB) : XB, rep_ ? (float*)(ws + WS_DUMMY + 96 * MiB) : part, args.in[I_NFIN], l == NL - 1, lane);
                if (rep_) GRID_BAR(); }
        }
        SEAM(pb + 10);
    }
#undef IN
#undef SEAM
#undef GRID_BAR
}

extern "C" void kernel_launch(void* const* d_in, const int* in_sizes, int n_in, void* d_out, int out_size, void* d_ws, size_t ws_size, hipStream_t stream) {
    static int grid = 0;
    if (grid == 0) {
        if (n_in != 24 || in_sizes[0] != T * DM || out_size != T * DM || ws_size < WS_END) {
            fprintf(stderr, "kernel_launch: shape mismatch: n_in %d in0 %d out %d ws %zu (need >= %zu); nothing launched\n", n_in, n_in > 0 ? in_sizes[0] : -1, out_size, ws_size, (size_t)WS_END); grid = -1; return; }
        int dev = 0, cus = 0, per_cu = 0;
        if (hipGetDevice(&dev) != hipSuccess || hipDeviceGetAttribute(&cus, hipDeviceAttributeMultiprocessorCount, dev) != hipSuccess) { fprintf(stderr, "kernel_launch: device query failed\n"); grid = -1; return; }
        if (hipFuncSetAttribute((const void*)fwd, hipFuncAttributeMaxDynamicSharedMemorySize, LDS_BYTES) != hipSuccess) { fprintf(stderr, "kernel_launch: hipFuncSetAttribute failed\n"); grid = -1; return; }
        if (hipOccupancyMaxActiveBlocksPerMultiprocessor(&per_cu, (const void*)fwd, 512, LDS_BYTES) != hipSuccess || per_cu < 1)
            fprintf(stderr, "kernel_launch: note: occupancy query reports %d workgroups per CU\n", per_cu);
        (void)hipGetLastError();
        grid = cus;
    }
    if (grid < 0) return;
    if (hipMemsetAsync((char*)d_ws + WS_CTL, 0, CTL_ZERO_BYTES, stream) != hipSuccess) { fprintf(stderr, "kernel_launch: memset failed\n"); return; }
    Args a{};
    for (int i = 0; i < 24; ++i) a.in[i] = (const float*)d_in[i];
    a.out = (float*)d_out; a.ws = (unsigned char*)d_ws;
#if MK_SPLIT
    for (int ph = 0; ph < NPHASE; ++ph) { a.ph_lo = ph; a.ph_hi = ph + 1; hipLaunchKernelGGL(fwd, dim3(grid), dim3(512), LDS_BYTES, stream, a); }
#else
    a.ph_lo = 0; a.ph_hi = NPHASE; hipLaunchKernelGGL(fwd, dim3(grid), dim3(512), LDS_BYTES, stream, a);
#endif
    const hipError_t le = hipPeekAtLastError();
    if (le != hipSuccess) fprintf(stderr, "kernel_launch: launch failed: %s\n", hipGetErrorName(le));
}
```

```cpp
#include <hip/hip_runtime.h>
#include <cstdio>
#include <cstdint>

#ifndef MK_SPLIT
#define MK_SPLIT 0
#endif

#define LAS __attribute__((address_space(3)))
#define GAS __attribute__((address_space(1)))
typedef unsigned short bf16_t;
typedef short bf16x8 __attribute__((ext_vector_type(8)));
typedef short s16x4 __attribute__((ext_vector_type(4)));
typedef float f32x2 __attribute__((ext_vector_type(2)));
typedef float f32x4 __attribute__((ext_vector_type(4)));
typedef float f32x16 __attribute__((ext_vector_type(16)));
typedef unsigned u32x2 __attribute__((ext_vector_type(2)));
typedef unsigned u32x4 __attribute__((ext_vector_type(4)));

constexpr int T = 16384, DM = 1024, NB = 8, SEQ = 2048, NL = 4, NMEM = 256, MT = NB * NMEM;
constexpr int INW = 8192, NE = 32, DE = 768, NHD = 8;
constexpr float EPS = 1e-6f;
constexpr float QSCALE = 0.18033688011112042f;
constexpr float CQSCALE = 0.09016844005556021f;
constexpr int MAXROWS = 40960;
constexpr int NPH_L = 11, NPHASE = 1 + NL * NPH_L;

constexpr size_t MiB = 1u << 20;
constexpr size_t WS_CTL = 0, CTL_ZERO_BYTES = 1 * MiB;
constexpr size_t WS_ROPE = 1 * MiB;
constexpr size_t WS_PART = 2 * MiB;
constexpr size_t WS_TOK = 3 * MiB;
constexpr size_t WS_ELIST = 4 * MiB;
constexpr size_t WS_MEMN = 6 * MiB;
constexpr size_t WS_KVC = 10 * MiB;
constexpr size_t WS_XB = 42 * MiB;
constexpr size_t WS_Q = 74 * MiB, WS_K = 106 * MiB, WS_V = 138 * MiB, WS_U = 170 * MiB, WS_CB = 202 * MiB;
constexpr size_t WS_G = 234 * MiB;
constexpr size_t WS_YA = 298 * MiB, WS_YC = 330 * MiB, WS_M = 362 * MiB;
constexpr size_t WS_QC = WS_Q, WS_OC = WS_K;
constexpr size_t WS_ACT = 394 * MiB;
constexpr size_t WS_Y = 454 * MiB;
constexpr size_t WS_W = 534 * MiB;
constexpr size_t WL_IN = 0, WL_BR = 16 * MiB, WL_O = 20 * MiB, WL_CQ = 22 * MiB, WL_CKV = 24 * MiB, WL_CO = 28 * MiB, WL_GU = 30 * MiB, WL_DN = 126 * MiB, WL_SZ = 174 * MiB;
constexpr size_t WS_END = WS_W + NL * WL_SZ;
constexpr size_t WS_DUMMY = WS_END;
constexpr int CW_BAR = 4096;
constexpr int CW_ECNT = 16384;

constexpr int RING_BYTES = 131072;
constexpr int LDSCTL_OFF = 145408;
constexpr int LDS_BYTES = 147456;
constexpr int LC_MISC = LDSCTL_OFF;
constexpr int LC_BST = LDSCTL_OFF + 256, LC_CNT = LDSCTL_OFF + 512, LC_BEXP = LDSCTL_OFF + 1024;

__device__ __forceinline__ unsigned cvt_pk_bf16(float lo, float hi) { unsigned r; asm volatile("v_cvt_pk_bf16_f32 %0, %1, %2" : "=v"(r) : "v"(lo), "v"(hi)); return r; }
__device__ __forceinline__ float bf_lo(unsigned w) { return __uint_as_float(w << 16); }
__device__ __forceinline__ float bf_hi(unsigned w) { return __uint_as_float(w & 0xffff0000u); }
template <int M> __device__ __forceinline__ float swz_xor(float v) { return __int_as_float(__builtin_amdgcn_ds_swizzle(__float_as_int(v), (M << 10) | 0x1f)); }
__device__ __forceinline__ float half_sum(float v) { auto rr = __builtin_amdgcn_permlane32_swap(__float_as_uint(v), __float_as_uint(v), false, false); return __uint_as_float(rr[0]) + __uint_as_float(rr[1]); }
__device__ __forceinline__ float sum32(float v) { v += swz_xor<1>(v); v += swz_xor<2>(v); v += swz_xor<4>(v); v += swz_xor<8>(v); v += swz_xor<16>(v); return v; }
__device__ __forceinline__ float wave_sum(float v) { return half_sum(sum32(v)); }
#define LDS_WAIT() asm volatile("s_waitcnt lgkmcnt(0)" ::: "memory")
#define VM_WAIT() asm volatile("s_waitcnt vmcnt(0)" ::: "memory")
__device__ __forceinline__ float lambda_init(int l) { return l == 0 ? 0.2f : l == 1 ? 0.35550906759096934f : l == 2 ? 0.4707130183435842f : 0.5560582041556406f; }
__device__ __forceinline__ float row_rscale(const float* part, int row) {
    const f32x4* p = (const f32x4*)(part + (size_t)row * 16);
    const f32x4 a = p[0], b = p[1], c = p[2], d = p[3];
    const float s = ((a[0] + a[1]) + (a[2] + a[3])) + ((b[0] + b[1]) + (b[2] + b[3])) + (((c[0] + c[1]) + (c[2] + c[3])) + ((d[0] + d[1]) + (d[2] + d[3])));
    return 1.0f / sqrtf(s * (1.0f / DM) + EPS);
}

__device__ __forceinline__ void row_rscale8(const float* part, const int (&rows)[2][4], int fq, float (&rs)[2][4]) {
    f32x4 v[2][4];
#pragma unroll
    for (int ai = 0; ai < 2; ++ai)
#pragma unroll
        for (int m = 0; m < 4; ++m) v[ai][m] = *(const f32x4*)(part + (size_t)rows[ai][m] * 16 + fq * 4);
#pragma unroll
    for (int ai = 0; ai < 2; ++ai)
#pragma unroll
        for (int m = 0; m < 4; ++m) { float s = (v[ai][m][0] + v[ai][m][1]) + (v[ai][m][2] + v[ai][m][3]); s += swz_xor<16>(s); s = half_sum(s); rs[ai][m] = 1.0f / sqrtf(s * (1.0f / DM) + EPS); }
}

namespace pg8 {
constexpr int BM = 256, BK = 64, HALF = 128, HTB = HALF * BK * 2, STAGE_BYTES = 8 * HTB;
__host__ __device__ __forceinline__ int lds_byte(int r, int c) { const int st = (r >> 4) * 2 + (c >> 5), rr = r & 15, cc = c & 31, ob = rr * 64 + cc * 2; return st * 1024 + (ob ^ (((ob >> 9) & 1) << 5)); }
__host__ __device__ __forceinline__ void stage_rc(int b, int& R, int& C) { const int st = b / 1024, sb = b % 1024, swz = sb ^ (((sb >> 9) & 1) << 5); R = (st >> 1) * 16 + swz / 64; C = (st & 1) * 32 + (swz % 64) / 2; }
__host__ __device__ __forceinline__ int perm32(int rho) { const int n = rho >> 4, i = rho & 15; return 8 * (i >> 2) + 4 * n + (i & 3); }

struct Unit { const char* A; const char* B; const int* gidx; int pm, pn, aux, nvalid; };

template <class Epi, class Sched, bool GATHER, bool ALIGN_EPI>
__device__ __forceinline__ void gemm_phase(LAS unsigned char* lds, const int K, const int lda, const Sched& S, const Epi& E) {
    int tid_ = threadIdx.x; asm volatile("" : "+v"(tid_));
    const int tid = tid_, wid = __builtin_amdgcn_readfirstlane(tid >> 6), lane = tid & 63, wr = wid >> 2, wc = wid & 3, fr = lane & 15, fq = lane >> 4;
    const int nt = K / BK;
    constexpr int NH = GATHER ? 2 : 1;
    unsigned voffB[2], voffA[NH][2], voffAn[NH][2];
#pragma unroll
    for (int i = 0; i < 2; ++i) { int R, C; stage_rc(tid * 16 + i * 8192, R, C); const int Rb = Epi::PERM ? ((R & ~31) + perm32(R & 31)) : R;
        voffB[i] = (unsigned)(Rb * K + C) * 2u; if constexpr (!GATHER) voffA[0][i] = (unsigned)(R * lda + C) * 2u; }
    const size_t kstep = (size_t)(BK * 2);
    const size_t hstepB = (size_t)HALF * K * 2, hstepA = GATHER ? 0 : (size_t)HALF * lda * 2;
    const unsigned ldsw = (unsigned)wid * 1024u;
    const int aoff = lds_byte(wr * 64 + fr, fq * 8), boff = lds_byte(wc * 32 + fr, fq * 8);
#define PG8_SA(b, h) (((b) * 2 + (h)) * HTB)
#define PG8_SB(b, h) ((4 + (b) * 2 + (h)) * HTB)
#define PG8_STAGE(bufoff, gbase, voff) do { _Pragma("unroll") for (int _i = 0; _i < 2; ++_i) \
        __builtin_amdgcn_global_load_lds((const unsigned*)((const char*)(gbase) + (voff)[_i]), (LAS unsigned*)(lds + (bufoff) + ldsw + _i * 8192), 16, 0, 0); } while (0)
#define PG8_STAGE_A(bufoff, gbase, h, nx) do { if constexpr (GATHER) { unsigned _v[2]; _v[0] = (nx) ? voffAn[h][0] : voffA[h][0]; _v[1] = (nx) ? voffAn[h][1] : voffA[h][1]; PG8_STAGE(bufoff, gbase, _v); } \
        else PG8_STAGE(bufoff, (gbase) + (h) * hstepA, voffA[0]); } while (0)
#define PG8_LDA(dst, b, h) do { _Pragma("unroll") for (int m = 0; m < 4; ++m) _Pragma("unroll") for (int k = 0; k < 2; ++k) dst[m][k] = *(const LAS bf16x8*)(lds + PG8_SA(b, h) + aoff + m * 2048 + k * 1024); } while (0)
#define PG8_LDB(dst, b, h) do { _Pragma("unroll") for (int n = 0; n < 2; ++n) _Pragma("unroll") for (int k = 0; k < 2; ++k) dst[n][k] = *(const LAS bf16x8*)(lds + PG8_SB(b, h) + boff + n * 2048 + k * 1024); } while (0)
#define PG8_MMA(ai, bj, At, Bt) do { __builtin_amdgcn_s_setprio(1); _Pragma("unroll") for (int m = 0; m < 4; ++m) _Pragma("unroll") for (int n = 0; n < 2; ++n) _Pragma("unroll") for (int k = 0; k < 2; ++k) \
        acc[ai][bj][m][n] = __builtin_amdgcn_mfma_f32_16x16x32_bf16(Bt[n][k], At[m][k], acc[ai][bj][m][n], 0, 0, 0); __builtin_amdgcn_s_setprio(0); } while (0)
#define PG8_WAIT_V(n) asm volatile("s_waitcnt vmcnt(" #n ")" ::: "memory")
#define PG8_WAIT_L(n) asm volatile("s_waitcnt lgkmcnt(" #n ")" ::: "memory")
#define PG8_BAR __builtin_amdgcn_s_barrier()
#define PG8_SCHED __builtin_amdgcn_sched_barrier(0)
#define PG8_VOFFA(dst, u) do { if constexpr (GATHER) { _Pragma("unroll") for (int _h = 0; _h < 2; ++_h) _Pragma("unroll") for (int _i = 0; _i < 2; ++_i) { \
        int _R, _C; stage_rc(tid * 16 + _i * 8192, _R, _C); const int _r = _h * HALF + _R; const int _t = (_r < (u).nvalid) ? (u).gidx[_r] : 0; dst[_h][_i] = (unsigned)(_t * lda + _C) * 2u; } } } while (0)
    Unit cur, nxt; int ui = 0;
    if (!S.next(0, cur)) return;
    PG8_VOFFA(voffA, cur);
    f32x4 acc[2][2][4][2];
#pragma unroll
    for (int a = 0; a < 2; ++a)
#pragma unroll
        for (int b = 0; b < 2; ++b)
#pragma unroll
            for (int m = 0; m < 4; ++m)
#pragma unroll
                for (int n = 0; n < 2; ++n) acc[a][b][m][n] = (f32x4){0.f, 0.f, 0.f, 0.f};
    bf16x8 At[4][2], B0[2][2], B1[2][2];
    const char* cA = cur.A; const char* cB = cur.B;
    PG8_STAGE(PG8_SB(0, 0), cB, voffB); PG8_STAGE(PG8_SB(0, 1), cB + hstepB, voffB); PG8_STAGE_A(PG8_SA(0, 0), cA, 0, false); PG8_STAGE_A(PG8_SA(0, 1), cA, 1, false);
    if (wr == 1) PG8_BAR;
    PG8_WAIT_V(2); PG8_BAR;
    PG8_STAGE(PG8_SB(1, 0), cB + kstep, voffB); PG8_STAGE_A(PG8_SA(1, 0), cA + kstep, 0, false); PG8_STAGE(PG8_SB(1, 1), cB + hstepB + kstep, voffB);
    PG8_WAIT_V(6); PG8_BAR;
    for (;;) {
        const bool has_next = S.next(ui + 1, nxt);
        if constexpr (GATHER) {
            if (has_next) { PG8_VOFFA(voffAn, nxt); }
            else {
#pragma unroll
                for (int h = 0; h < NH; ++h)
#pragma unroll
                    for (int i = 0; i < 2; ++i) voffAn[h][i] = voffA[h][i];
            }
        }
        const char* nA = has_next ? nxt.A : cA; const char* nB = has_next ? nxt.B : cB;
        for (int t = 0; t < nt; t += 2) {
            const bool last = (t == nt - 2);
            const char* a1 = cA + (size_t)(t + 1) * kstep;
            const char* a2 = last ? nA : cA + (size_t)(t + 2) * kstep; const char* b2 = last ? nB : cB + (size_t)(t + 2) * kstep;
            const char* a3 = a2 + kstep; const char* b3 = b2 + kstep;
            PG8_LDB(B0, 0, 0); PG8_LDB(B1, 0, 1); PG8_SCHED; PG8_LDA(At, 0, 0); PG8_STAGE_A(PG8_SA(1, 1), a1, 1, false);
            PG8_WAIT_V(8); PG8_WAIT_L(0); PG8_BAR; PG8_MMA(0, 0, At, B0); PG8_MMA(0, 1, At, B1); PG8_BAR; PG8_SCHED;
            PG8_LDA(At, 0, 1); PG8_STAGE(PG8_SB(0, 0), b2, voffB); PG8_STAGE(PG8_SB(0, 1), b2 + hstepB, voffB); PG8_STAGE_A(PG8_SA(0, 0), a2, 0, last);
            PG8_WAIT_V(8); PG8_WAIT_L(0); PG8_BAR; PG8_MMA(1, 0, At, B0); PG8_MMA(1, 1, At, B1); PG8_BAR; PG8_SCHED;
            PG8_LDB(B0, 1, 0); PG8_LDB(B1, 1, 1); PG8_SCHED; PG8_LDA(At, 1, 0); PG8_STAGE_A(PG8_SA(0, 1), a2, 1, last);
            PG8_WAIT_V(8); PG8_WAIT_L(0); PG8_BAR; PG8_MMA(0, 0, At, B0); PG8_MMA(0, 1, At, B1); PG8_BAR; PG8_SCHED;
            PG8_LDA(At, 1, 1); PG8_STAGE(PG8_SB(1, 0), b3, voffB); PG8_STAGE(PG8_SB(1, 1), b3 + hstepB, voffB); PG8_STAGE_A(PG8_SA(1, 0), a3, 0, last);
            PG8_WAIT_V(8); PG8_WAIT_L(0); PG8_BAR; PG8_MMA(1, 0, At, B0); PG8_MMA(1, 1, At, B1); PG8_BAR; PG8_SCHED;
        }
        if constexpr (ALIGN_EPI) { if (wr == 0) PG8_BAR; }
        const bool keep = E(acc, cur, wr, wc, fr, fq);
        if (!has_next) break;
        if (!keep) {
#pragma unroll
            for (int a = 0; a < 2; ++a)
#pragma unroll
                for (int b = 0; b < 2; ++b)
#pragma unroll
                    for (int m = 0; m < 4; ++m)
#pragma unroll
                        for (int n = 0; n < 2; ++n) acc[a][b][m][n] = (f32x4){0.f, 0.f, 0.f, 0.f};
        }
        cur = nxt; cA = nA; cB = nB; ++ui;
        if constexpr (GATHER) {
#pragma unroll
            for (int h = 0; h < NH; ++h)
#pragma unroll
                for (int i = 0; i < 2; ++i) voffA[h][i] = voffAn[h][i];
        }
        if constexpr (ALIGN_EPI) { if (wr == 1) PG8_BAR; }
    }
    PG8_WAIT_V(0);
    if constexpr (!ALIGN_EPI) { if (wr == 0) PG8_BAR; }
    PG8_BAR;
#undef PG8_SA
#undef PG8_SB
#undef PG8_STAGE
#undef PG8_STAGE_A
#undef PG8_LDA
#undef PG8_LDB
#undef PG8_MMA
#undef PG8_WAIT_V
#undef PG8_WAIT_L
#undef PG8_BAR
#undef PG8_SCHED
#undef PG8_VOFFA
}
}

struct DenseSched {
    const char* A; const char* B; size_t astep, bstep; int nM, nN, nwg, G, c;
    __device__ __forceinline__ void init(const void* A_, const void* B_, int M, int N, int K, int lda, int G_, int c_) {
        A = (const char*)A_; B = (const char*)B_; astep = (size_t)256 * lda * 2; bstep = (size_t)256 * K * 2; nM = M / 256; nN = N / 256; nwg = nM * nN; G = G_; c = c_; }
    __device__ __forceinline__ bool next(int i, pg8::Unit& u) const {
        const long L = (long)i * G + c; if (L >= nwg) return false;
        int wgid = (int)L; { const int q = nwg / 8, r = nwg % 8, xcd = wgid % 8, off = wgid / 8; wgid = (xcd < r ? xcd * (q + 1) : r * (q + 1) + (xcd - r) * q) + off; }
        const int nig = 8 * nN, gid = wgid / nig, fm = gid * 8, gsz = (nM - fm) < 8 ? (nM - fm) : 8;
        u.pm = fm + ((wgid % nig) % gsz); u.pn = (wgid % nig) / gsz; u.aux = 0; u.gidx = nullptr; u.nvalid = 256;
        u.A = A + (size_t)u.pm * astep; u.B = B + (size_t)u.pn * bstep; return true;
    }
};
struct BrSched {
    DenseSched d; const char* A1; const char* B1;
    __device__ __forceinline__ bool next(int i, pg8::Unit& u) const {
        if (!d.next(i >> 1, u)) return false;
        if (i & 1) { u.A = A1 + (size_t)u.pm * d.astep; u.B = B1 + (size_t)u.pn * d.bstep; u.aux = 1; }
        return true;
    }
};
struct KvcSched {
    const char* A; const char* B; int G, c;
    __device__ __forceinline__ bool next(int i, pg8::Unit& u) const {
        const int L = i * G + c; if (L >= 256) return false;
        const int l = L >> 6, r = L & 63; u.pm = r & 7; u.pn = r >> 3; u.aux = l; u.gidx = nullptr; u.nvalid = 256;
        u.A = A + (size_t)u.pm * (256 * DM * 2); u.B = B + (size_t)l * WL_SZ + (size_t)u.pn * (256 * DM * 2); return true;
    }
};
struct MoeSched {
    const LAS int* bst; const LAS int* cnt; const LAS int* bexp; const char* A; const char* B; const int* elist; size_t estride, tstride; int ntile, G, c; bool gather;
    __device__ __forceinline__ bool next(int i, pg8::Unit& u) const {
        const int nblk = bst[32]; const int L = i * G + c; if (L >= nblk * ntile) return false;
        const int blk = L / ntile, j = L - blk * ntile;
        const int e = __builtin_amdgcn_readfirstlane(bexp[blk]);
        const int rb = blk - __builtin_amdgcn_readfirstlane(bst[e]); const int ce = __builtin_amdgcn_readfirstlane(cnt[e]);
        u.pm = blk; u.pn = j; u.aux = e; u.nvalid = (ce - rb * 256) < 256 ? (ce - rb * 256) : 256;
        u.gidx = elist + (size_t)e * T + rb * 256;
        u.A = gather ? A : A + (size_t)blk * 256 * DE * 2;
        u.B = B + (size_t)e * estride + (size_t)j * tstride; return true;
    }
};

__device__ __forceinline__ void st8(bf16_t* p, f32x4 v0, f32x4 v1) {
    u32x4 w; w.x = cvt_pk_bf16(v0[0], v0[1]); w.y = cvt_pk_bf16(v0[2], v0[3]); w.z = cvt_pk_bf16(v1[0], v1[1]); w.w = cvt_pk_bf16(v1[2], v1[3]); *(u32x4*)p = w; }
__device__ __forceinline__ float sigmoidf_(float x) { return 1.0f / (1.0f + __expf(-x)); }

struct EpiIn {
    static constexpr bool PERM = true;
    const float* part; const float* cosT; const float* sinT; bf16_t *Q, *Kb, *V, *U, *CB, *G;
    __device__ __forceinline__ bool operator()(f32x4 (&acc)[2][2][4][2], const pg8::Unit& u, int wr, int wc, int fr, int fq) const {
        const int pn = u.pn, row0 = u.pm * 256 + wr * 64 + fr;
        float rs_[2][4]; { int rows_[2][4];
#pragma unroll
            for (int ai = 0; ai < 2; ++ai)
#pragma unroll
                for (int m = 0; m < 4; ++m) rows_[ai][m] = row0 + ai * 128 + m * 16;
            row_rscale8(part, rows_, fq, rs_); }
#define RS_AT(ai, m) rs_[ai][m]
#define EFENCE() asm volatile("" ::: "memory")
        if (pn < 8) {
            bf16_t* dst = pn < 4 ? Q : Kb; const float sc = pn < 4 ? QSCALE : 1.0f; const int colb = (pn & 3) * 256 + wc * 32 + 8 * fq;
            const bool rot = ((wc & 1) == 0) && (fq < 2);
#pragma unroll
            for (int ai = 0; ai < 2; ++ai)
#pragma unroll
                for (int m = 0; m < 4; ++m) { const int row = row0 + ai * 128 + m * 16; f32x4 c4 = {1.f, 1.f, 1.f, 1.f}, s4 = {0.f, 0.f, 0.f, 0.f}; const float rsv = RS_AT(ai, m);
                    if (rot) { const int t = row & (SEQ - 1); c4 = *(const f32x4*)(cosT + t * 8 + 4 * fq); s4 = *(const f32x4*)(sinT + t * 8 + 4 * fq); }
#pragma unroll
                    for (int bj = 0; bj < 2; ++bj) { f32x4 x1 = acc[ai][bj][m][0] * rsv, x2 = acc[ai][bj][m][1] * rsv;
                        const f32x4 y1 = x1 * c4 - x2 * s4, y2 = x2 * c4 + x1 * s4;
                        if (rot) { x1 = y1; x2 = y2; }
                        st8(dst + (size_t)row * DM + colb + bj * 128, x1 * sc, x2 * sc); } EFENCE(); }
        } else if (pn < 16) {
            bf16_t* dst = pn < 12 ? V : CB; const int colb = (pn & 3) * 256 + wc * 32 + 8 * fq;
#pragma unroll
            for (int ai = 0; ai < 2; ++ai)
#pragma unroll
                for (int m = 0; m < 4; ++m) { const int row = row0 + ai * 128 + m * 16; const float rsv = RS_AT(ai, m);
#pragma unroll
                    for (int bj = 0; bj < 2; ++bj) st8(dst + (size_t)row * DM + colb + bj * 128, acc[ai][bj][m][0] * rsv, acc[ai][bj][m][1] * rsv); EFENCE(); }
        } else if (pn < 24) {
            const int colb = (pn - 16) * 128 + wc * 32 + 8 * fq;
#pragma unroll
            for (int ai = 0; ai < 2; ++ai)
#pragma unroll
                for (int m = 0; m < 4; ++m) { const int row = row0 + ai * 128 + m * 16; const float rsv = RS_AT(ai, m); const float r2 = rsv * rsv;
                    st8(U + (size_t)row * DM + colb, acc[ai][0][m][0] * acc[ai][1][m][0] * r2, acc[ai][0][m][1] * acc[ai][1][m][1] * r2); EFENCE(); }
        } else {
            const int colb = (pn - 24) * 256 + wc * 32 + 8 * fq;
#pragma unroll
            for (int ai = 0; ai < 2; ++ai)
#pragma unroll
                for (int m = 0; m < 4; ++m) { const int row = row0 + ai * 128 + m * 16; const float rsv = RS_AT(ai, m);
#pragma unroll
                    for (int bj = 0; bj < 2; ++bj) { f32x4 a = acc[ai][bj][m][0] * rsv, b = acc[ai][bj][m][1] * rsv;
#pragma unroll
                        for (int j = 0; j < 4; ++j) { a[j] = sigmoidf_(a[j]); b[j] = sigmoidf_(b[j]); }
                        st8(G + (size_t)row * 2048 + colb + bj * 128, a, b); } EFENCE(); }
        }
#undef RS_AT
        return false;
    }
};
struct EpiPlain {
    static constexpr bool PERM = true;
    bf16_t* O; int ldc; const float* part; float scale; size_t aux_stride;
    __device__ __forceinline__ bool operator()(f32x4 (&acc)[2][2][4][2], const pg8::Unit& u, int wr, int wc, int fr, int fq) const {
        const int row0 = u.pm * 256 + wr * 64 + fr, colb = u.pn * 256 + wc * 32 + 8 * fq; bf16_t* base = O + (size_t)u.aux * aux_stride;
        float rs_[2][4];
        if (part) { int rows_[2][4];
#pragma unroll
            for (int ai = 0; ai < 2; ++ai)
#pragma unroll
                for (int m = 0; m < 4; ++m) rows_[ai][m] = row0 + ai * 128 + m * 16;
            row_rscale8(part, rows_, fq, rs_); }
#pragma unroll
        for (int ai = 0; ai < 2; ++ai)
#pragma unroll
            for (int m = 0; m < 4; ++m) { const int row = row0 + ai * 128 + m * 16; const float s = part ? rs_[ai][m] * scale : scale;
#pragma unroll
                for (int bj = 0; bj < 2; ++bj) st8(base + (size_t)row * ldc + colb + bj * 128, acc[ai][bj][m][0] * s, acc[ai][bj][m][1] * s); }
        return false;
    }
};
struct EpiRes {
    static constexpr bool PERM = false;
    const float* xin; float* xout; bf16_t* xb; float* part;
    __device__ __forceinline__ bool operator()(f32x4 (&acc)[2][2][4][2], const pg8::Unit& u, int wr, int wc, int fr, int fq) const {
        const int row0 = u.pm * 256 + wr * 64 + fr, col0 = u.pn * 256 + wc * 32 + 4 * fq;
#pragma unroll
        for (int ai = 0; ai < 2; ++ai)
#pragma unroll
            for (int m = 0; m < 4; ++m) { const int row = row0 + ai * 128 + m * 16; float ss = 0.f;
#pragma unroll
                for (int bj = 0; bj < 2; ++bj)
#pragma unroll
                    for (int n = 0; n < 2; ++n) { const size_t off = (size_t)row * DM + col0 + bj * 128 + n * 16;
                        const f32x4 xv = *(const f32x4*)(xin + off) + acc[ai][bj][m][n]; *(f32x4*)(xout + off) = xv;
                        ss += (xv[0] * xv[0] + xv[1] * xv[1]) + (xv[2] * xv[2] + xv[3] * xv[3]);
                        u32x2 w; w.x = cvt_pk_bf16(xv[0], xv[1]); w.y = cvt_pk_bf16(xv[2], xv[3]); *(u32x2*)(xb + off) = w; }
                ss += swz_xor<16>(ss); ss = half_sum(ss);
                if (fq == 0) part[(size_t)row * 16 + u.pn * 4 + wc] = ss; }
        return false;
    }
};
struct EpiBr {
    static constexpr bool PERM = true;
    const bf16_t* G; bf16_t* Mo;
    __device__ __forceinline__ bool operator()(f32x4 (&acc)[2][2][4][2], const pg8::Unit& u, int wr, int wc, int fr, int fq) const {
        const int row0 = u.pm * 256 + wr * 64 + fr, colb = u.pn * 256 + wc * 32 + 8 * fq; const bool first = (u.aux == 0);
#pragma unroll
        for (int ai = 0; ai < 2; ++ai)
#pragma unroll
            for (int m = 0; m < 4; ++m) { const int row = row0 + ai * 128 + m * 16;
#pragma unroll
                for (int bj = 0; bj < 2; ++bj) { const u32x4 g0 = *(const u32x4*)(G + (size_t)row * 2048 + colb + bj * 128), g1 = *(const u32x4*)(G + (size_t)row * 2048 + 1024 + colb + bj * 128);
                    f32x4 a0 = {bf_lo(g0.x), bf_hi(g0.x), bf_lo(g0.y), bf_hi(g0.y)}, a1 = {bf_lo(g0.z), bf_hi(g0.z), bf_lo(g0.w), bf_hi(g0.w)};
                    f32x4 b0 = {bf_lo(g1.x), bf_hi(g1.x), bf_lo(g1.y), bf_hi(g1.y)}, b1 = {bf_lo(g1.z), bf_hi(g1.z), bf_lo(g1.w), bf_hi(g1.w)};
                    if (first) {
#pragma unroll
                        for (int j = 0; j < 4; ++j) { acc[ai][bj][m][0][j] *= a0[j] / b0[j]; acc[ai][bj][m][1][j] *= a1[j] / b1[j]; }
                    } else st8(Mo + (size_t)row * DM + colb + bj * 128, acc[ai][bj][m][0] * b0, acc[ai][bj][m][1] * b1); } }
        return first;
    }
};
struct EpiGU {
    static constexpr bool PERM = true;
    const float* part; bf16_t* ACT;
    __device__ __forceinline__ bool operator()(f32x4 (&acc)[2][2][4][2], const pg8::Unit& u, int wr, int wc, int fr, int fq) const {
        const int colb = u.pn * 128 + wc * 32 + 8 * fq;
        float rs_[2][4]; { int rows_[2][4];
#pragma unroll
            for (int ai = 0; ai < 2; ++ai)
#pragma unroll
                for (int m = 0; m < 4; ++m) { const int rl = ai * 128 + wr * 64 + m * 16 + fr; rows_[ai][m] = (rl < u.nvalid) ? u.gidx[rl] : 0; }
            row_rscale8(part, rows_, fq, rs_); }
#pragma unroll
        for (int ai = 0; ai < 2; ++ai)
#pragma unroll
            for (int m = 0; m < 4; ++m) { const int rl = ai * 128 + wr * 64 + m * 16 + fr; const float s = rs_[ai][m];
                f32x4 o[2];
#pragma unroll
                for (int n = 0; n < 2; ++n) { const f32x4 g = acc[ai][0][m][n] * s, up = acc[ai][1][m][n] * s;
#pragma unroll
                    for (int j = 0; j < 4; ++j) o[n][j] = g[j] * sigmoidf_(g[j]) * up[j]; }
                st8(ACT + (size_t)(u.pm * 256 + rl) * DE + colb, o[0], o[1]); }
        return false;
    }
};

namespace att {
#define SBAR() __builtin_amdgcn_sched_barrier(0)
constexpr float THR2 = 11.541560327111707f;
__device__ __forceinline__ int crow(int r, int hi) { return (r & 3) + 8 * (r >> 2) + 4 * hi; }
template <int DQK> __device__ __forceinline__ int kswz(int row, int colB) {
    if constexpr (DQK == 64) return row * 128 + (colB ^ (((row >> 1) & 7) << 4));
    else return row * 512 + (colB ^ ((row & 15) << 4));
}
__device__ __forceinline__ void partialSM(f32x16& p0, f32x16& p1, float& m_reg, float& mn, float& alpha) {
    float pmax = p0[0];
#pragma unroll
    for (int r = 1; r < 16; ++r) pmax = fmaxf(pmax, p0[r]);
#pragma unroll
    for (int r = 0; r < 16; ++r) pmax = fmaxf(pmax, p1[r]);
    { auto rr = __builtin_amdgcn_permlane32_swap(__float_as_uint(pmax), __float_as_uint(pmax), false, false);
      pmax = fmaxf(__uint_as_float(rr[0]), __uint_as_float(rr[1])); }
    if (__builtin_expect(__all(pmax - m_reg <= THR2), 1)) { mn = m_reg; alpha = 1.f; }
    else { mn = fmaxf(m_reg, pmax); alpha = __builtin_amdgcn_exp2f(m_reg - mn); m_reg = mn; }
#pragma unroll
    for (int r = 0; r < 16; ++r) p0[r] = p0[r] - mn;
#pragma unroll
    for (int r = 0; r < 16; ++r) p1[r] = p1[r] - mn;
#pragma unroll
    for (int r = 0; r < 16; ++r) p0[r] = __builtin_amdgcn_exp2f(p0[r]);
}
__device__ __forceinline__ void finishSM(f32x16& p0, f32x16& p1, float alpha, float& l_reg, bf16x8& pa0, bf16x8& pa1, bf16x8& pa2, bf16x8& pa3) {
#pragma unroll
    for (int r = 0; r < 16; ++r) p1[r] = __builtin_amdgcn_exp2f(p1[r]);
    float ps = 0;
#pragma unroll
    for (int r = 0; r < 16; ++r) ps += p0[r];
#pragma unroll
    for (int r = 0; r < 16; ++r) ps += p1[r];
    { auto rr = __builtin_amdgcn_permlane32_swap(__float_as_uint(ps), __float_as_uint(ps), false, false);
      ps = __uint_as_float(rr[0]) + __uint_as_float(rr[1]); }
    l_reg = l_reg * alpha + ps;
#define PK4(P, BASE, OUT) do { unsigned a0 = cvt_pk_bf16(P[BASE + 0], P[BASE + 1]), a1 = cvt_pk_bf16(P[BASE + 2], P[BASE + 3]);   \
    unsigned b0 = cvt_pk_bf16(P[BASE + 4], P[BASE + 5]), b1 = cvt_pk_bf16(P[BASE + 6], P[BASE + 7]);                              \
    auto r0 = __builtin_amdgcn_permlane32_swap(a0, b0, false, false); auto r1 = __builtin_amdgcn_permlane32_swap(a1, b1, false, false); \
    u32x4 w = {r0[0], r1[0], r0[1], r1[1]}; OUT = *reinterpret_cast<bf16x8*>(&w); } while (0)
    PK4(p0, 0, pa0); PK4(p0, 8, pa1); PK4(p1, 0, pa2); PK4(p1, 8, pa3);
#undef PK4
}
template <int DQK> __device__ __forceinline__ void qkt(f32x16& p0, f32x16& p1, const char* Ks, const bf16x8* qr, int r32, int hi) {
    p0 = f32x16{}; p1 = f32x16{};
#pragma unroll
    for (int d0 = 0; d0 < DQK / 16; ++d0) { const int cb = (d0 * 16 + hi * 8) * 2;
        const bf16x8 b0 = *reinterpret_cast<const bf16x8*>(Ks + kswz<DQK>(r32, cb));
        const bf16x8 b1 = *reinterpret_cast<const bf16x8*>(Ks + kswz<DQK>(32 + r32, cb));
        p0 = __builtin_amdgcn_mfma_f32_32x32x16_bf16(b0, qr[d0], p0, 0, 0, 0);
        p1 = __builtin_amdgcn_mfma_f32_32x32x16_bf16(b1, qr[d0], p1, 0, 0, 0); }
}
__device__ __forceinline__ int v_st(int k, int c) { const int kk = (k & ~0xC) | ((k & 4) << 1) | ((k & 8) >> 1); return ((kk >> 3) * 4 + (c >> 5)) * 512 + ((kk & 7) * 32 + (c & 31)) * 2; }
__device__ __forceinline__ int v_rd_base(int lane) { return ((lane & 3) << 3) | (((lane >> 2) & 3) << 6) | (((lane >> 4) & 1) << 5) | (((lane >> 5) & 1) << 8); }
constexpr int v_rd_off(int d0, int ks, int half) { return d0 * 512 + ks * 4096 + half * 2048; }
template <int OFF> __device__ __forceinline__ s16x4 tr_read(int vb) {
    s16x4 r; asm volatile("ds_read_b64_tr_b16 %0, %1 offset:%2" : "=&v"(r) : "v"(vb), "i"(OFF) : "memory"); return r;
}
template <int D0> __device__ __forceinline__ void pv_one(f32x16& od, int vb, bf16x8 pa0, bf16x8 pa1, bf16x8 pa2, bf16x8 pa3) {
    const s16x4 l0 = tr_read<v_rd_off(D0, 0, 0)>(vb), h0 = tr_read<v_rd_off(D0, 0, 1)>(vb), l1 = tr_read<v_rd_off(D0, 1, 0)>(vb), h1 = tr_read<v_rd_off(D0, 1, 1)>(vb);
    const s16x4 l2 = tr_read<v_rd_off(D0, 2, 0)>(vb), h2 = tr_read<v_rd_off(D0, 2, 1)>(vb), l3 = tr_read<v_rd_off(D0, 3, 0)>(vb), h3 = tr_read<v_rd_off(D0, 3, 1)>(vb);
    asm volatile("s_waitcnt lgkmcnt(0)" ::: "memory"); SBAR();
#define PK(L, H) (bf16x8){L[0], L[1], L[2], L[3], H[0], H[1], H[2], H[3]}
    od = __builtin_amdgcn_mfma_f32_32x32x16_bf16(pa0, PK(l0, h0), od, 0, 0, 0);
    od = __builtin_amdgcn_mfma_f32_32x32x16_bf16(pa1, PK(l1, h1), od, 0, 0, 0);
    od = __builtin_amdgcn_mfma_f32_32x32x16_bf16(pa2, PK(l2, h2), od, 0, 0, 0);
    od = __builtin_amdgcn_mfma_f32_32x32x16_bf16(pa3, PK(l3, h3), od, 0, 0, 0);
#undef PK
}
__device__ __forceinline__ void pv_d0(f32x16* o, int vb, bf16x8 pa0, bf16x8 pa1, bf16x8 pa2, bf16x8 pa3) {
    pv_one<0>(o[0], vb, pa0, pa1, pa2, pa3); pv_one<1>(o[1], vb, pa0, pa1, pa2, pa3); pv_one<2>(o[2], vb, pa0, pa1, pa2, pa3); pv_one<3>(o[3], vb, pa0, pa1, pa2, pa3);
}

constexpr int SHM_V = 16384, SHM_K64 = 8192, DA_NBUF = 3, DA_LDS = DA_NBUF * SHM_V + DA_NBUF * SHM_K64 + 8 * 256;
__device__ __forceinline__ void qkt64c(f32x16& p0, f32x16& p1, const char* Ks, const bf16x8* qr, const f32x16& cinit, int r32, int hi) {
#pragma unroll
    for (int d0 = 0; d0 < 4; ++d0) { const int cb = (d0 * 16 + hi * 8) * 2;
        const bf16x8 b0 = *reinterpret_cast<const bf16x8*>(Ks + kswz<64>(r32, cb));
        const bf16x8 b1 = *reinterpret_cast<const bf16x8*>(Ks + kswz<64>(32 + r32, cb));
        if (d0 == 0) { p0 = __builtin_amdgcn_mfma_f32_32x32x16_bf16(b0, qr[0], cinit, 0, 0, 0); p1 = __builtin_amdgcn_mfma_f32_32x32x16_bf16(b1, qr[0], cinit, 0, 0, 0); }
        else { p0 = __builtin_amdgcn_mfma_f32_32x32x16_bf16(b0, qr[d0], p0, 0, 0, 0); p1 = __builtin_amdgcn_mfma_f32_32x32x16_bf16(b1, qr[d0], p1, 0, 0, 0); } }
}
__device__ __forceinline__ float rowmax32(const f32x16& p0, const f32x16& p1) {
#define MX3(a, b, c) __builtin_fmaxf(__builtin_fmaxf((a), (b)), (c))
    float a = MX3(p0[0], p0[1], p1[0]), b = MX3(p0[2], p0[3], p1[1]); a = MX3(a, p1[2], p1[3]);
#pragma unroll
    for (int r = 4; r < 16; r += 4) { a = MX3(a, p0[r], p0[r + 1]); b = MX3(b, p0[r + 2], p0[r + 3]); a = MX3(a, p1[r], p1[r + 1]); b = MX3(b, p1[r + 2], p1[r + 3]); }
#undef MX3
    float m = __builtin_fmaxf(a, b);
    auto rr = __builtin_amdgcn_permlane32_swap(__float_as_uint(m), __float_as_uint(m), false, false);
    return __builtin_fmaxf(__uint_as_float(rr[0]), __uint_as_float(rr[1]));
}
__device__ __forceinline__ void partialSMc(f32x16& p0, f32x16& p1, float& m_reg, f32x16& negm, float& alpha) {
    const float pmax = rowmax32(p0, p1);
    alpha = 1.f;
    if (__builtin_expect(!__all(pmax <= THR2), 0)) {
        const float d = __builtin_fmaxf(pmax, 0.f); m_reg += d; alpha = __builtin_amdgcn_exp2f(-d);
#pragma unroll
        for (int r = 0; r < 16; ++r) { p0[r] -= d; p1[r] -= d; }
#pragma unroll
        for (int r = 0; r < 16; ++r) negm[r] = -m_reg;
    }
#pragma unroll
    for (int r = 0; r < 16; ++r) p0[r] = __builtin_amdgcn_exp2f(p0[r]);
}

__device__ __forceinline__ void diff_pass(const bf16_t* __restrict__ Qb, const bf16_t* __restrict__ Kh, const bf16_t* __restrict__ Vh, int seq, char* lds, f32x16 (&o)[4]) {
    int tid_ = threadIdx.x; asm volatile("" : "+v"(tid_));
    const int tid = tid_, wid = tid >> 6, lane = tid & 63, r32 = lane & 31, hi = lane >> 5;
    char* V_lds = lds; char* K_lds = lds + DA_NBUF * SHM_V;
    float* ws = (float*)(lds + DA_NBUF * SHM_V + DA_NBUF * SHM_K64) + wid * 64; float* li_l = ws; float* al_l = ws + 32;
    float m_reg = 0.f, l_reg = 0;
#pragma unroll
    for (int d = 0; d < 4; ++d) o[d] = f32x16{};
    bf16x8 qr[4];
    const bf16_t* Qw = Qb + (size_t)(wid * 32 + r32) * DM + hi * 8;
#pragma unroll
    for (int d0 = 0; d0 < 4; ++d0) qr[d0] = *reinterpret_cast<const bf16x8*>(Qw + d0 * 16);
    const int sr = tid >> 4, sc = (tid & 15) * 8, vst0 = v_st(sr, sc), vst1 = v_st(32 + sr, sc);
    const int kr = tid >> 3, kc = (tid & 7) * 8, kst = kswz<64>(kr, kc * 2);
    const int vb0 = (int)(uintptr_t)V_lds + v_rd_base(lane);
    bf16x8 vs0, vs1, ks;
#define SLOAD(k0) do { vs0 = *reinterpret_cast<const bf16x8*>(&Vh[(size_t)((k0) + sr) * DM + sc]); vs1 = *reinterpret_cast<const bf16x8*>(&Vh[(size_t)((k0) + 32 + sr) * DM + sc]); \
    ks = *reinterpret_cast<const bf16x8*>(&Kh[(size_t)((k0) + kr) * DM + kc]); } while (0)
#define SWRITE(s) do { *(bf16x8*)(V_lds + (s) * SHM_V + vst0) = vs0; *(bf16x8*)(V_lds + (s) * SHM_V + vst1) = vs1; *(bf16x8*)(K_lds + (s) * SHM_K64 + kst) = ks; } while (0)
#define RESC(a) do { if (__any((a) < 1.f)) { if (hi == 0) al_l[r32] = (a); asm volatile("s_waitcnt lgkmcnt(0)" ::: "memory"); \
    _Pragma("unroll") for (int d = 0; d < 4; ++d) _Pragma("unroll") for (int r = 0; r < 16; ++r) o[d][r] *= al_l[crow(r, hi)]; } } while (0)
#define ROT() do { s_prev = s_cur; s_cur = s_next; s_next = (s_next == DA_NBUF - 1) ? 0 : s_next + 1; } while (0)
    f32x16 pA0, pA1, pB0, pB1, negm; float alA, alB; bf16x8 pa0, pa1, pa2, pa3; const int NT = seq / 64;
    int s_prev = 0, s_cur = 0, s_next = 1;
    __syncthreads();
    SLOAD(0); SWRITE(0); SLOAD(64); __syncthreads();
    negm = f32x16{};
    qkt64c(pA0, pA1, K_lds, qr, negm, r32, hi);
    { const float pm = rowmax32(pA0, pA1); m_reg = pm; alA = 1.f;
#pragma unroll
      for (int r = 0; r < 16; ++r) { pA0[r] -= pm; pA1[r] -= pm; negm[r] = -pm; }
#pragma unroll
      for (int r = 0; r < 16; ++r) pA0[r] = __builtin_amdgcn_exp2f(pA0[r]); }
    SWRITE(1); __syncthreads();
    ROT();
    for (int j = 1; j + 1 < NT; j += 2) {
        SLOAD((j + 1) * 64);
        SBAR(); qkt64c(pB0, pB1, K_lds + s_cur * SHM_K64, qr, negm, r32, hi);
        finishSM(pA0, pA1, alA, l_reg, pa0, pa1, pa2, pa3); SBAR();
        pv_d0(o, vb0 + s_prev * SHM_V, pa0, pa1, pa2, pa3); partialSMc(pB0, pB1, m_reg, negm, alB);
        SWRITE(s_next); RESC(alB); __syncthreads(); ROT();
        SLOAD((j + 2) * 64);
        SBAR(); qkt64c(pA0, pA1, K_lds + s_cur * SHM_K64, qr, negm, r32, hi);
        finishSM(pB0, pB1, alB, l_reg, pa0, pa1, pa2, pa3); SBAR();
        pv_d0(o, vb0 + s_prev * SHM_V, pa0, pa1, pa2, pa3); partialSMc(pA0, pA1, m_reg, negm, alA);
        SWRITE(s_next); RESC(alA); __syncthreads(); ROT();
    }
    SBAR(); qkt64c(pB0, pB1, K_lds + s_cur * SHM_K64, qr, negm, r32, hi);
    finishSM(pA0, pA1, alA, l_reg, pa0, pa1, pa2, pa3); SBAR();
    pv_d0(o, vb0 + s_prev * SHM_V, pa0, pa1, pa2, pa3); partialSMc(pB0, pB1, m_reg, negm, alB);
    RESC(alB);
    finishSM(pB0, pB1, alB, l_reg, pa0, pa1, pa2, pa3); SBAR();
    pv_d0(o, vb0 + s_cur * SHM_V, pa0, pa1, pa2, pa3);
    if (hi == 0) li_l[r32] = l_reg; asm volatile("s_waitcnt lgkmcnt(0)" ::: "memory");
#pragma unroll
    for (int r = 0; r < 16; ++r) { const float rl = __builtin_amdgcn_rcpf(li_l[crow(r, hi)]);
#pragma unroll
        for (int d = 0; d < 4; ++d) o[d][r] *= rl; }
#undef SLOAD
#undef SWRITE
#undef RESC
#undef ROT
}
__device__ __forceinline__ void diff_unit(int b, int h, int qb, const bf16_t* Q, const bf16_t* K, const bf16_t* V, bf16_t* YA, float lam, float omli, const float* subln, char* lds) {
    int tid_ = threadIdx.x; asm volatile("" : "+v"(tid_));
    const int tid = tid_, wid = tid >> 6, lane = tid & 63, r32 = lane & 31, hi = lane >> 5;
    const size_t rowbase = (size_t)b * SEQ; const int q0 = qb * 256;
    const bf16_t* Qb = Q + (rowbase + q0) * DM + h * 128;
    const bf16_t* Kh = K + rowbase * DM + h * 128;
    const bf16_t* Vh = V + rowbase * DM + h * 128;
    f32x16 o[4];
    diff_pass(Qb, Kh, Vh, SEQ, lds, o);
    unsigned* park = (unsigned*)(lds + DA_LDS) + wid * 2048 + lane;
#pragma unroll
    for (int d = 0; d < 4; ++d)
#pragma unroll
        for (int r = 0; r < 8; ++r) park[(d * 8 + r) * 64] = cvt_pk_bf16(o[d][2 * r], o[d][2 * r + 1]);
    diff_pass(Qb + 64, Kh + 64, Vh, SEQ, lds, o);
    asm volatile("s_waitcnt lgkmcnt(0)" ::: "memory");
    float ss[16];
#pragma unroll
    for (int r = 0; r < 16; ++r) { float s = 0.f;
#pragma unroll
        for (int d = 0; d < 4; ++d) { const unsigned pw = park[(d * 8 + (r >> 1)) * 64]; const float a = (r & 1) ? bf_hi(pw) : bf_lo(pw); const float v = a - lam * o[d][r]; o[d][r] = v; s += v * v; }
        ss[r] = s; }
#pragma unroll
    for (int r = 0; r < 16; ++r) {
        ss[r] = sum32(ss[r]);
        ss[r] = omli / sqrtf(ss[r] * (1.0f / 128.0f) + EPS); }
    float gl[4];
#pragma unroll
    for (int d = 0; d < 4; ++d) gl[d] = subln[32 * d + r32];
    bf16_t* Ow = YA + (rowbase + q0 + wid * 32) * DM + h * 128 + r32;
#pragma unroll
    for (int r = 0; r < 16; ++r) { const int orow = crow(r, hi);
#pragma unroll
        for (int d = 0; d < 4; ++d) Ow[(size_t)orow * DM + 32 * d] = (bf16_t)(cvt_pk_bf16(o[d][r] * ss[r] * gl[d], 0.f) & 0xffffu); }
}

constexpr int CA_LDS = 32768 + 32768 + 8 * 256;
__device__ __forceinline__ void cross_unit(int b, int hd, int qb, const bf16_t* QC, const bf16_t* KV, bf16_t* OC, char* lds) {
    int tid_ = threadIdx.x; asm volatile("" : "+v"(tid_));
    const int tid = tid_, wid = tid >> 6, lane = tid & 63, r32 = lane & 31, hi = lane >> 5, vimg = wid >> 2;
    char* K_lds = lds; char* V_lds = lds + 32768; float* ws = (float*)(lds + 65536) + wid * 64; float* li_l = ws; float* al_l = ws + 32;
    const size_t qrow = (size_t)b * SEQ + qb * 128 + (wid & 3) * 32;
    const bf16_t* Qw = QC + (qrow + r32) * DM + hd * 256 + hi * 8;
    bf16x8 qr[16];
#pragma unroll
    for (int d0 = 0; d0 < 16; ++d0) qr[d0] = *reinterpret_cast<const bf16x8*>(Qw + d0 * 16);
    const bf16_t* Kh = KV + (size_t)(b * NMEM) * 2048 + hd * 256; const bf16_t* Vh = Kh + 1024;
    const int kr = tid >> 3, kc8 = tid & 7, sr = tid >> 4, sc = (tid & 15) * 8, vst0 = v_st(sr, sc), vst1 = v_st(32 + sr, sc);
    const int vb0 = (int)(uintptr_t)V_lds + vimg * SHM_V + v_rd_base(lane);
    float m_reg = -1e30f, l_reg = 0; f32x16 o[4];
#pragma unroll
    for (int d = 0; d < 4; ++d) o[d] = f32x16{};
    for (int t = 0; t < 4; ++t) {
        const int k0 = t * 64;
        __syncthreads();
        { bf16x8 kk[4];
#pragma unroll
          for (int j = 0; j < 4; ++j) kk[j] = *reinterpret_cast<const bf16x8*>(&Kh[(size_t)(k0 + kr) * 2048 + (kc8 + 8 * j) * 8]);
#pragma unroll
          for (int j = 0; j < 4; ++j) *(bf16x8*)(K_lds + kswz<256>(kr, (kc8 + 8 * j) * 16)) = kk[j]; }
        asm volatile("" ::: "memory");
        { bf16x8 vv[4];
          vv[0] = *reinterpret_cast<const bf16x8*>(&Vh[(size_t)(k0 + sr) * 2048 + sc]);       vv[1] = *reinterpret_cast<const bf16x8*>(&Vh[(size_t)(k0 + 32 + sr) * 2048 + sc]);
          vv[2] = *reinterpret_cast<const bf16x8*>(&Vh[(size_t)(k0 + sr) * 2048 + 128 + sc]); vv[3] = *reinterpret_cast<const bf16x8*>(&Vh[(size_t)(k0 + 32 + sr) * 2048 + 128 + sc]);
          *(bf16x8*)(V_lds + vst0) = vv[0]; *(bf16x8*)(V_lds + vst1) = vv[1]; *(bf16x8*)(V_lds + SHM_V + vst0) = vv[2]; *(bf16x8*)(V_lds + SHM_V + vst1) = vv[3]; }
        __syncthreads();
        f32x16 p0, p1; float mn, al; bf16x8 pa0, pa1, pa2, pa3;
        qkt<256>(p0, p1, K_lds, qr, r32, hi); partialSM(p0, p1, m_reg, mn, al);
        if (__any(al < 1.f)) { if (hi == 0) al_l[r32] = al; asm volatile("s_waitcnt lgkmcnt(0)" ::: "memory");
#pragma unroll
            for (int d = 0; d < 4; ++d)
#pragma unroll
                for (int r = 0; r < 16; ++r) o[d][r] *= al_l[crow(r, hi)]; }
        finishSM(p0, p1, al, l_reg, pa0, pa1, pa2, pa3); SBAR();
        pv_d0(o, vb0, pa0, pa1, pa2, pa3);
    }
    if (hi == 0) li_l[r32] = l_reg; asm volatile("s_waitcnt lgkmcnt(0)" ::: "memory");
    bf16_t* Ow = OC + qrow * DM + hd * 256 + vimg * 128 + r32;
#pragma unroll
    for (int r = 0; r < 16; ++r) { const float rl = __builtin_amdgcn_rcpf(li_l[crow(r, hi)]); const int orow = crow(r, hi);
#pragma unroll
        for (int d = 0; d < 4; ++d) Ow[(size_t)orow * DM + 32 * d] = (bf16_t)(cvt_pk_bf16(o[d][r] * rl, 0.f) & 0xffffu); }
    __syncthreads();
}
#undef SBAR
}

__device__ __forceinline__ f32x4 ld_bf4(const bf16_t* p) { const u32x2 w = *(const u32x2*)p; return (f32x4){bf_lo(w.x), bf_hi(w.x), bf_lo(w.y), bf_hi(w.y)}; }
__device__ __forceinline__ void st_bf4(bf16_t* p, f32x4 v) { u32x2 w; w.x = cvt_pk_bf16(v[0], v[1]); w.y = cvt_pk_bf16(v[2], v[3]); *(u32x2*)p = w; }
__device__ __forceinline__ void ld_bf8(const bf16_t* p, f32x4& a, f32x4& b) { const u32x4 w = *(const u32x4*)p; a = (f32x4){bf_lo(w.x), bf_hi(w.x), bf_lo(w.y), bf_hi(w.y)}; b = (f32x4){bf_lo(w.z), bf_hi(w.z), bf_lo(w.w), bf_hi(w.w)}; }

__device__ __forceinline__ void conv_rows(const bf16_t* U, const bf16_t* CB, const float* cw, bf16_t* YC, int gw, int NGW, int lane) {
    for (int g = gw; g < T / 8; g += NGW) { const int t0 = g * 8;
#pragma unroll
        for (int c2 = 0; c2 < 2; ++c2) { const int col = c2 * 512 + lane * 8;
            f32x4 w0a = *(const f32x4*)(cw + col), w0b = *(const f32x4*)(cw + col + 4), w1a = *(const f32x4*)(cw + DM + col), w1b = *(const f32x4*)(cw + DM + col + 4),
                  w2a = *(const f32x4*)(cw + 2 * DM + col), w2b = *(const f32x4*)(cw + 2 * DM + col + 4);
            f32x4 pa = {0.f, 0.f, 0.f, 0.f}, pb = pa, ca, cb_, na, nb;
            if ((t0 & (SEQ - 1)) != 0) ld_bf8(U + (size_t)(t0 - 1) * DM + col, pa, pb);
            ld_bf8(U + (size_t)t0 * DM + col, ca, cb_);
            for (int i = 0; i < 8; ++i) { const int t = t0 + i;
                if (((t + 1) & (SEQ - 1)) != 0) ld_bf8(U + (size_t)(t + 1) * DM + col, na, nb); else { na = (f32x4){0.f, 0.f, 0.f, 0.f}; nb = na; }
                f32x4 ga, gb; ld_bf8(CB + (size_t)t * DM + col, ga, gb);
                st8(YC + (size_t)t * DM + col, ga * (w0a * pa + w1a * ca + w2a * na), gb * (w0b * pb + w1b * cb_ + w2b * nb));
                pa = ca; pb = cb_; ca = na; cb_ = nb; } } }
}
__device__ __forceinline__ void x0_row(const float* xrow, bf16_t* xbrow, float* prow, int lane) {
    const f32x4* xr = (const f32x4*)xrow + lane; float s = 0.f;
#pragma unroll
    for (int j = 0; j < 4; ++j) { const f32x4 v = xr[64 * j]; s += (v[0] * v[0] + v[1] * v[1]) + (v[2] * v[2] + v[3] * v[3]); st_bf4(xbrow + j * 256 + lane * 4, v); }
    s = wave_sum(s);
    if (lane < 16) prow[lane] = lane == 0 ? s : 0.f;
}
__device__ __forceinline__ void memn_row(const float* xrow, const float* g, bf16_t* orow, int lane) {
    const f32x4* xr = (const f32x4*)xrow + lane; const f32x4* gr = (const f32x4*)g + lane; f32x4 v[4]; float s = 0.f;
#pragma unroll
    for (int j = 0; j < 4; ++j) { v[j] = xr[64 * j]; s += (v[j][0] * v[j][0] + v[j][1] * v[j][1]) + (v[j][2] * v[j][2] + v[j][3] * v[j][3]); }
    const float r = 1.0f / sqrtf(wave_sum(s) * (1.0f / DM) + EPS);
#pragma unroll
    for (int j = 0; j < 4; ++j) st_bf4(orow + j * 256 + lane * 4, v[j] * r * gr[64 * j]);
}
__device__ __forceinline__ void combine_row(int t, const LAS int* bst, const int* tok_e, const int* tok_pos, const float* tok_w, const bf16_t* Y, const float* xi, float* xio, bf16_t* xb, float* part, const float* gfin, bool last, int lane) {
    const int e0 = tok_e[2 * t], e1 = tok_e[2 * t + 1]; const float w0 = tok_w[2 * t], w1 = tok_w[2 * t + 1];
    const size_t s0 = (size_t)bst[e0] * 256 + tok_pos[2 * t], s1 = (size_t)bst[e1] * 256 + tok_pos[2 * t + 1];
    f32x4 v[4]; float s = 0.f;
#pragma unroll
    for (int j = 0; j < 4; ++j) { const int c = j * 256 + lane * 4;
        v[j] = *(const f32x4*)(xi + (size_t)t * DM + c) + w0 * ld_bf4(Y + s0 * DM + c) + w1 * ld_bf4(Y + s1 * DM + c);
        s += (v[j][0] * v[j][0] + v[j][1] * v[j][1]) + (v[j][2] * v[j][2] + v[j][3] * v[j][3]); }
    s = wave_sum(s);
    if (!last) {
#pragma unroll
        for (int j = 0; j < 4; ++j) { const int c = j * 256 + lane * 4; *(f32x4*)(xio + (size_t)t * DM + c) = v[j]; st_bf4(xb + (size_t)t * DM + c, v[j]); }
        if (lane < 16) part[(size_t)t * 16 + lane] = lane == 0 ? s : 0.f;
    } else {
        const float r = 1.0f / sqrtf(s * (1.0f / DM) + EPS);
#pragma unroll
        for (int j = 0; j < 4; ++j) { const int c = j * 256 + lane * 4; *(f32x4*)(xio + (size_t)t * DM + c) = v[j] * r * *(const f32x4*)(gfin + c); }
    }
}
__device__ __forceinline__ void route_token(int t, const float* x, const float* part, const float (&gf)[16], const f32x4 (&wg)[16], const LAS char* WeL,
                                            unsigned* ecnt, int* elist, int* tok_e, int* tok_pos, float* tok_w, int lane) {
    float pp = lane < 16 ? part[(size_t)t * 16 + lane] : 0.f; pp = wave_sum(pp);
    const float rs = 1.0f / sqrtf(pp * (1.0f / DM) + EPS);
    float hv[16]; f32x4 ag = {0.f, 0.f, 0.f, 0.f};
#pragma unroll
    for (int j = 0; j < 16; ++j) { hv[j] = x[(size_t)t * DM + j * 64 + lane] * rs * gf[j]; ag += hv[j] * wg[j]; }
    float a0 = wave_sum(ag[0]), a1 = wave_sum(ag[1]), a2 = wave_sum(ag[2]), a3 = wave_sum(ag[3]);
    int gi = 0; float am = a0; if (a1 > am) { am = a1; gi = 1; } if (a2 > am) { am = a2; gi = 2; } if (a3 > am) { am = a3; gi = 3; }
    const float gw_ = 1.0f / (__expf(a0 - am) + __expf(a1 - am) + __expf(a2 - am) + __expf(a3 - am));
    gi = __builtin_amdgcn_readfirstlane(gi);
    f32x4 ea = {0.f, 0.f, 0.f, 0.f}, eb = ea;
#pragma unroll
    for (int j = 0; j < 16; ++j) { const int k = j * 64 + lane; const int sw = (k >> 1) & 7;
        const f32x4 wa = *(const LAS f32x4*)(WeL + k * 128 + (((2 * gi) ^ sw) << 4)), wb = *(const LAS f32x4*)(WeL + k * 128 + (((2 * gi + 1) ^ sw) << 4));
        ea += hv[j] * wa; eb += hv[j] * wb; }
    float e[8];
#pragma unroll
    for (int q = 0; q < 4; ++q) { e[q] = wave_sum(ea[q]); e[4 + q] = wave_sum(eb[q]); }
    int i1 = 0; float e1v = e[0];
#pragma unroll
    for (int q = 1; q < 8; ++q) if (e[q] > e1v) { e1v = e[q]; i1 = q; }
    int i2 = (i1 == 0) ? 1 : 0; float e2v = -3.0e38f;
#pragma unroll
    for (int q = 0; q < 8; ++q) if (q != i1 && e[q] > e2v) { e2v = e[q]; i2 = q; }
    const float z = __expf(e2v - e1v); const float w1 = gw_ / (1.0f + z), w2 = gw_ * z / (1.0f + z);
    if (lane == 0) {
        const int x1 = gi * 8 + i1, x2 = gi * 8 + i2;
        const int p1 = (int)atomicAdd(ecnt + x1 * 64, 1u), p2 = (int)atomicAdd(ecnt + x2 * 64, 1u);
        elist[(size_t)x1 * T + p1] = t; elist[(size_t)x2 * T + p2] = t;
        tok_e[2 * t] = x1; tok_e[2 * t + 1] = x2; tok_pos[2 * t] = p1; tok_pos[2 * t + 1] = p2; tok_w[2 * t] = w1; tok_w[2 * t + 1] = w2;
    }
}

__device__ __forceinline__ int map_row(int mode, int n) {
    if (mode == 1) {
        if (n < 2048) { const int d = n & 63; const int p = (d >= 4 && d < 8) ? d + 4 : (d >= 8 && d < 12) ? d - 4 : d; return (n & ~63) + p; }
        if (n >= 4096 && n < 5120) { const int q = n - 4096; return 4096 + (q >> 7) * 256 + (q & 127); }
        if (n >= 5120 && n < 6144) { const int q = n - 5120; return 4096 + (q >> 7) * 256 + 128 + (q & 127); }
        return n;
    }
    if (mode == 2) return (n >> 7) * 256 + (n & 127);
    if (mode == 3) return (n >> 7) * 256 + 128 + (n & 127);
    return n;
}
__device__ __forceinline__ void transpose_item(const float* W, int ldw, int k0, int n0, const float* gain, bf16_t* WT, int ldt, int mode, LAS float* scr, int lane) {
    f32x4 v[16];
#pragma unroll
    for (int i = 0; i < 16; ++i) v[i] = *(const f32x4*)(W + (size_t)(k0 + 4 * i + (lane >> 4)) * ldw + n0 + (lane & 15) * 4);
    if (gain) {
#pragma unroll
        for (int i = 0; i < 16; ++i) v[i] = v[i] * gain[k0 + 4 * i + (lane >> 4)];
    }
#pragma unroll
    for (int i = 0; i < 16; ++i) { LAS float* s = scr + (4 * i + (lane >> 4)) * 65 + (lane & 15) * 4; s[0] = v[i][0]; s[1] = v[i][1]; s[2] = v[i][2]; s[3] = v[i][3]; }
    LDS_WAIT(); asm volatile("" ::: "memory");
    const int c = lane & 7;
#pragma unroll
    for (int j = 0; j < 8; ++j) { const int n = (lane >> 3) + 8 * j; const LAS float* s = scr + (8 * c) * 65 + n;
        u32x4 o; o.x = cvt_pk_bf16(s[0 * 65], s[1 * 65]); o.y = cvt_pk_bf16(s[2 * 65], s[3 * 65]); o.z = cvt_pk_bf16(s[4 * 65], s[5 * 65]); o.w = cvt_pk_bf16(s[6 * 65], s[7 * 65]);
        *(u32x4*)(WT + (size_t)map_row(mode, n0 + n) * ldt + k0 + 8 * c) = o; }
    LDS_WAIT(); asm volatile("" ::: "memory");
}
constexpr int IT_IN = 2048, IT_BR = 512, IT_SQ = 256, IT_KV = 512, IT_EXP = 576, IT_LAYER = IT_IN + IT_BR + 3 * IT_SQ + IT_KV + 32 * IT_EXP;
__device__ __forceinline__ void rope_entry(int idx, float* cosT, float* sinT) {
    const int t = idx >> 3, i = idx & 7;
    const double inv = i == 0 ? 1.0 : i == 1 ? 0.19392274474868576 : i == 2 ? 0.03760603093086393 : i == 3 ? 0.007292664737217109 : i == 4 ? 0.001414213562373095 : i == 5 ? 0.0002742481756762073 : i == 6 ? 5.318295896944988e-05 : 1.031338537721246e-05;
    const double ang = (double)t * inv;
    const double kq = __builtin_rint(ang * 0.6366197723675814);
    const double r = (ang - kq * 1.5707963267341256) - kq * 6.077100506506192e-11;
    const double r2 = r * r;
    double sn = 1.0 / 6227020800.0; sn = sn * r2 - 1.0 / 39916800.0; sn = sn * r2 + 1.0 / 362880.0; sn = sn * r2 - 1.0 / 5040.0; sn = sn * r2 + 1.0 / 120.0; sn = sn * r2 - 1.0 / 6.0; sn = sn * r2 + 1.0; sn = sn * r;
    double cs = 1.0 / 479001600.0; cs = cs * r2 - 1.0 / 3628800.0; cs = cs * r2 + 1.0 / 40320.0; cs = cs * r2 - 1.0 / 720.0; cs = cs * r2 + 1.0 / 24.0; cs = cs * r2 - 0.5; cs = cs * r2 + 1.0;
    const int q = ((int)kq) & 3;
    const double c = q == 0 ? cs : q == 1 ? -sn : q == 2 ? -cs : sn;
    const double s = q == 0 ? sn : q == 1 ? cs : q == 2 ? -sn : -cs;
    cosT[idx] = (float)c; sinT[idx] = (float)s;
}

#define XB_TMO      128
#define XB_XCNT(j)  (256  + 64 * (j))
#define XB_XSUB(j)  (1280 + 64 * (j))
#define XB_XGEN(j)  (2304 + 64 * (j))
#define XB_TOP      3328
#define XB_TOPGEN   3392
#define XCD_BAR_WORDS 3456
#define XB_SPIN_CAP (1u << 18)
__device__ __forceinline__ unsigned xb_ld(unsigned* p)              { return __hip_atomic_load(p, __ATOMIC_RELAXED, __HIP_MEMORY_SCOPE_AGENT); }
__device__ __forceinline__ unsigned xb_add(unsigned* p, unsigned v) { return __hip_atomic_fetch_add(p, v, __ATOMIC_RELAXED, __HIP_MEMORY_SCOPE_AGENT); }
__device__ __forceinline__ unsigned xb_xcc_id() { return (unsigned)__builtin_amdgcn_s_getreg((3 << 11) | 20) & 0xFu; }
#define XB_SPIN(cond, bar) do { unsigned _sp = 0; while (cond) { __builtin_amdgcn_s_sleep(1); \
    if ((++_sp & 255u) == 0u) { if (xb_ld(&(bar)[XB_TMO])) break; if (_sp > XB_SPIN_CAP) { atomicAdd(&(bar)[XB_TMO], 1u); break; } } } } while (0)
struct XcdBarrier { unsigned* bar; unsigned x; volatile LAS unsigned* st; };
__device__ __forceinline__ XcdBarrier xcd_barrier_post(unsigned* bar, volatile LAS unsigned* st) {
    XcdBarrier b; b.bar = bar; b.x = (unsigned)__builtin_amdgcn_readfirstlane((int)xb_xcc_id()); b.st = st;
    if (threadIdx.x == 0) (void)xb_add(&bar[XB_XCNT(b.x)], 1u);
    return b;
}
__device__ __forceinline__ void xcd_barrier_complete(unsigned* bar, unsigned x, unsigned& nloc, unsigned& nx) {
    const unsigned G = gridDim.x * gridDim.y * gridDim.z;
    unsigned sum, cnt, mine, sp = 0u;
    for (;;) {
        sum = 0u; cnt = 0u; mine = 0u;
#pragma unroll
        for (unsigned j = 0; j < 16; ++j) { const unsigned c = xb_ld(&bar[XB_XCNT(j)]); sum += c; cnt += (c > 0u) ? 1u : 0u; mine = (j == x) ? c : mine; }
        if (sum == G) break;
        __builtin_amdgcn_s_sleep(1);
        if ((++sp & 255u) == 0u) { if (xb_ld(&bar[XB_TMO])) break; if (sp > XB_SPIN_CAP) { atomicAdd(&bar[XB_TMO], 1u); break; } }
    }
    nloc = mine > 0u ? mine : 1u; nx = cnt > 0u ? cnt : 1u;
}
__device__ __forceinline__ void xcd_barrier(const XcdBarrier& b) {
    asm volatile("s_waitcnt vmcnt(0)" ::: "memory");
    __syncthreads();
    int t0_ = threadIdx.x; asm volatile("" : "+v"(t0_));
    if (t0_ == 0) {
        unsigned* bar = b.bar; unsigned bx_ = b.x;
        asm volatile("" : "+s"(bar), "+s"(bx_));
        __builtin_amdgcn_s_waitcnt(0);
        unsigned nloc = b.st[0], nx = b.st[1];
        if (nloc == 0u) { xcd_barrier_complete(bar, bx_, nloc, nx); b.st[0] = nloc; b.st[1] = nx; }
        const unsigned old = xb_add(&bar[XB_XSUB(bx_)], 1u);
        const unsigned gen = old / nloc;
        if (old + 1u == (gen + 1u) * nloc) {
            __builtin_amdgcn_fence(__ATOMIC_RELEASE, "agent");
            asm volatile("s_waitcnt vmcnt(0)" ::: "memory");
            const unsigned og = xb_add(&bar[XB_TOP], 1u);
            const unsigned tg = og / nx;
            if (og + 1u == (tg + 1u) * nx) xb_add(&bar[XB_TOPGEN], 1u);
            else XB_SPIN(xb_ld(&bar[XB_TOPGEN]) == tg, bar);
            __builtin_amdgcn_fence(__ATOMIC_ACQUIRE, "agent");
            xb_add(&bar[XB_XGEN(bx_)], 1u);
            asm volatile("s_waitcnt vmcnt(0)" ::: "memory");
        } else {
            XB_SPIN(xb_ld(&bar[XB_XGEN(bx_)]) == gen, bar);
            __builtin_amdgcn_fence(__ATOMIC_ACQUIRE, "agent");
            asm volatile("s_waitcnt vmcnt(0)" ::: "memory");
        }
    }
    __syncthreads();
}

struct Args { const float* in[24]; float* out; unsigned char* ws; int ph_lo, ph_hi; };
enum { I_X = 0, I_MEM, I_NMIX, I_WIN, I_LQ1, I_LK1, I_LQ2, I_LK2, I_SUBLN, I_CONVW, I_WBR, I_WO, I_NCROSS, I_NMEM, I_WCQ, I_WCKV, I_WCO, I_NFFN, I_WRG, I_WRE, I_WG, I_WU, I_WD, I_NFIN };

__global__ void __launch_bounds__(512, 2) fwd(Args args) {
    extern __shared__ __attribute__((aligned(16))) unsigned char lds_raw[];
    LAS unsigned char* lds = (LAS unsigned char*)lds_raw;
    const int tid = threadIdx.x, lane = tid & 63, wave = __builtin_amdgcn_readfirstlane(tid >> 6);
    const int G = gridDim.x, bx = blockIdx.x, vcu = (G % 8 == 0) ? (bx % 8) * (G / 8) + bx / 8 : bx;
    const int gw0 = vcu * 8 + wave, NGW = G * 8;
    unsigned char* ws = args.ws;
    unsigned* ctl = (unsigned*)(ws + WS_CTL);
    for (int u = tid; u < (LDS_BYTES - LDSCTL_OFF) / 4; u += 512) ((LAS unsigned*)(lds + LDSCTL_OFF))[u] = 0u;
    __syncthreads();
    volatile LAS unsigned* MISC = (volatile LAS unsigned*)(lds + LC_MISC);
    LAS int* bst = (LAS int*)(lds + LC_BST); LAS int* cntL = (LAS int*)(lds + LC_CNT); LAS int* bexp = (LAS int*)(lds + LC_BEXP);
#if MK_SPLIT
    XcdBarrier bar; bar.bar = ctl + CW_BAR; bar.x = 0; bar.st = nullptr;
#define GRID_BAR() do { } while (0)
#else
    XcdBarrier bar = xcd_barrier_post(ctl + CW_BAR, MISC + 8);
#define GRID_BAR() do { xcd_barrier(bar); if ((PROBE_MASK >> 12) & 1) xcd_barrier(bar); } while (0)
#endif
    const int lo = args.ph_lo, hi_ = args.ph_hi; (void)lo; (void)hi_;
#ifndef PH_MASK
#define PH_MASK 0xfff
#endif
#define PEN(j) (((PH_MASK) >> (j)) & 1)
#ifndef PROBE_MASK
#define PROBE_MASK 0
#endif
#define NREP(j) ((((PROBE_MASK) >> (j)) & 1) ? 2 : 1)
#if MK_SPLIT
#define IN(k) (lo <= (k) && (k) < hi_)
#else
#define IN(k) true
#endif
#define OPQ_LANE() int tid_o_ = threadIdx.x, gw_o_ = gw0; asm volatile("" : "+v"(tid_o_), "+s"(gw_o_)); const int tid = tid_o_, lane = tid_o_ & 63, gw = gw_o_; (void)tid; (void)lane; (void)gw
#define SEAM(k) do { if (IN(k) && IN((k) + 1)) GRID_BAR(); } while (0)
    float* cosT = (float*)(ws + WS_ROPE); float* sinT = cosT + SEQ * 8;
    float* part = (float*)(ws + WS_PART);
    int* tok_e = (int*)(ws + WS_TOK); int* tok_pos = tok_e + 2 * T; float* tok_w = (float*)(tok_pos + 2 * T);
    int* elist = (int*)(ws + WS_ELIST);
    bf16_t* memn = (bf16_t*)(ws + WS_MEMN); bf16_t* KVC = (bf16_t*)(ws + WS_KVC); bf16_t* XB = (bf16_t*)(ws + WS_XB);
    bf16_t* Qb = (bf16_t*)(ws + WS_Q); bf16_t* Kb = (bf16_t*)(ws + WS_K); bf16_t* Vb = (bf16_t*)(ws + WS_V); bf16_t* Ub = (bf16_t*)(ws + WS_U); bf16_t* CBb = (bf16_t*)(ws + WS_CB);
    bf16_t* Gb = (bf16_t*)(ws + WS_G); bf16_t* YA = (bf16_t*)(ws + WS_YA); bf16_t* YC = (bf16_t*)(ws + WS_YC); bf16_t* Mb = (bf16_t*)(ws + WS_M);
    bf16_t* QC = (bf16_t*)(ws + WS_QC); bf16_t* OC = (bf16_t*)(ws + WS_OC); bf16_t* ACT = (bf16_t*)(ws + WS_ACT); bf16_t* Yb = (bf16_t*)(ws + WS_Y);
    float* xs = args.out;

    for (int rep_ = 0; rep_ < NREP(11); ++rep_) { if (IN(0) && PEN(11)) {
        OPQ_LANE();
        LAS float* scr = (LAS float*)(lds + wave * 16640);
        for (int it = gw; it < NL * IT_LAYER; it += NGW) {
            const int l = it / IT_LAYER; int r = it - l * IT_LAYER; unsigned char* wl = ws + WS_W + (size_t)l * WL_SZ;
            if (r < IT_IN) { transpose_item(args.in[I_WIN] + (size_t)l * DM * INW, INW, (r >> 7) * 64, (r & 127) * 64, args.in[I_NMIX] + l * DM, (bf16_t*)(wl + WL_IN), DM, 1, scr, lane); continue; } r -= IT_IN;
            if (r < IT_BR) { const int n = r >> 8, q = r & 255; transpose_item(args.in[I_WBR] + (size_t)(l * 2 + n) * DM * DM, DM, (q >> 4) * 64, (q & 15) * 64, nullptr, (bf16_t*)(wl + WL_BR) + (size_t)n * DM * DM, DM, 0, scr, lane); continue; } r -= IT_BR;
            if (r < IT_SQ) { transpose_item(args.in[I_WO] + (size_t)l * DM * DM, DM, (r >> 4) * 64, (r & 15) * 64, nullptr, (bf16_t*)(wl + WL_O), DM, 0, scr, lane); continue; } r -= IT_SQ;
            if (r < IT_SQ) { transpose_item(args.in[I_WCQ] + (size_t)l * DM * DM, DM, (r >> 4) * 64, (r & 15) * 64, args.in[I_NCROSS] + l * DM, (bf16_t*)(wl + WL_CQ), DM, 0, scr, lane); continue; } r -= IT_SQ;
            if (r < IT_KV) { transpose_item(args.in[I_WCKV] + (size_t)l * DM * 2048, 2048, (r >> 5) * 64, (r & 31) * 64, nullptr, (bf16_t*)(wl + WL_CKV), DM, 0, scr, lane); continue; } r -= IT_KV;
            if (r < IT_SQ) { transpose_item(args.in[I_WCO] + (size_t)l * DM * DM, DM, (r >> 4) * 64, (r & 15) * 64, nullptr, (bf16_t*)(wl + WL_CO), DM, 0, scr, lane); continue; } r -= IT_SQ;
            const int e = r / IT_EXP, r3 = r - e * IT_EXP, ty = r3 / 192, r4 = r3 - ty * 192;
            if (ty < 2) transpose_item(args.in[ty == 0 ? I_WG : I_WU] + (size_t)(l * NE + e) * DM * DE, DE, (r4 / 12) * 64, (r4 % 12) * 64, args.in[I_NFFN] + l * DM, (bf16_t*)(wl + WL_GU) + (size_t)e * 1536 * DM, DM, 2 + ty, scr, lane);
            else transpose_item(args.in[I_WD] + (size_t)(l * NE + e) * DE * DM, DM, (r4 >> 4) * 64, (r4 & 15) * 64, nullptr, (bf16_t*)(wl + WL_DN) + (size_t)e * DM * DE, DE, 0, scr, lane);
        }
        for (int m = gw; m < MT; m += NGW) memn_row(args.in[I_MEM] + (size_t)m * DM, args.in[I_NMEM], memn + (size_t)m * DM, lane);
        for (int m = gw; m < T; m += NGW) x0_row(args.in[I_X] + (size_t)m * DM, XB + (size_t)m * DM, part + (size_t)m * 16, lane);
        for (int i = vcu * 512 + tid; i < SEQ * 8; i += G * 512) rope_entry(i, cosT, sinT);
    } if (rep_ + 1 < NREP(11)) GRID_BAR(); }
    SEAM(0);

    for (int l = 0; l < NL; ++l) {
        const int pb = 1 + NPH_L * l;
        unsigned char* wl = ws + WS_W + (size_t)l * WL_SZ;
        const float* xin = (l == 0) ? args.in[I_X] : xs;
        unsigned* ecnt = ctl + CW_ECNT + l * 32 * 64;
        for (int rep_ = 0; rep_ < NREP(0); ++rep_) { if (IN(pb + 0) && PEN(0)) {
            { DenseSched S; S.init(XB, wl + WL_IN, T, INW, DM, DM, G, bx);
              EpiIn E{part, cosT, sinT, Qb, Kb, Vb, Ub, CBb, Gb};
              pg8::gemm_phase<EpiIn, DenseSched, false, true>(lds, DM, DM, S, E); }
            if (l == 0) { KvcSched S{(const char*)memn, (const char*)(ws + WS_W + WL_CKV), G, bx};
              EpiPlain E{KVC, 2048, nullptr, 1.0f, (size_t)MT * 2048};
              pg8::gemm_phase<EpiPlain, KvcSched, false, true>(lds, DM, DM, S, E); }
        } if (rep_ + 1 < NREP(0)) GRID_BAR(); }
        SEAM(pb + 0);
        for (int rep_ = 0; rep_ < NREP(1); ++rep_) { if (IN(pb + 1) && PEN(1)) {
            OPQ_LANE();
            conv_rows(Ub, CBb, args.in[I_CONVW] + (size_t)l * 3 * DM, YC, gw, NGW, lane);
            const float s1 = wave_sum(args.in[I_LQ1][l * 64 + lane] * args.in[I_LK1][l * 64 + lane]), s2 = wave_sum(args.in[I_LQ2][l * 64 + lane] * args.in[I_LK2][l * 64 + lane]);
            const float li = lambda_init(l), lam = expf(s1) - expf(s2) + li;
            for (int u = vcu; u < NB * NHD * 8; u += G) { const int bh = u >> 3, qb = u & 7;
                att::diff_unit(bh >> 3, bh & 7, qb, Qb, Kb, Vb, YA, lam, 1.0f - li, args.in[I_SUBLN] + l * 128, (char*)lds_raw); }
            __syncthreads();
        } if (rep_ + 1 < NREP(1)) GRID_BAR(); }
        SEAM(pb + 1);
        for (int rep_ = 0; rep_ < NREP(2); ++rep_) { if (IN(pb + 2) && PEN(2)) {
            BrSched S; S.d.init(YA, wl + WL_BR, T, DM, DM, DM, G, bx); S.A1 = (const char*)YC; S.B1 = (const char*)(wl + WL_BR) + (size_t)DM * DM * 2;
            EpiBr E{Gb, Mb};
            pg8::gemm_phase<EpiBr, BrSched, false, true>(lds, DM, DM, S, E);
        } if (rep_ + 1 < NREP(2)) GRID_BAR(); }
        SEAM(pb + 2);
        for (int rep_ = NREP(3) - 1; rep_ >= 0; --rep_) { if (IN(pb + 3) && PEN(3)) {
            DenseSched S; S.init(Mb, wl + WL_O, T, DM, DM, DM, G, bx);
            EpiRes E{xin, rep_ ? (float*)(ws + WS_DUMMY) : xs, rep_ ? (bf16_t*)(ws + WS_DUMMY + 64 * MiB) : XB, rep_ ? (float*)(ws + WS_DUMMY + 96 * MiB) : part};
            pg8::gemm_phase<EpiRes, DenseSched, false, true>(lds, DM, DM, S, E);
        } if (rep_) GRID_BAR(); }
        SEAM(pb + 3);
        for (int rep_ = 0; rep_ < NREP(4); ++rep_) { if (IN(pb + 4) && PEN(4)) {
            DenseSched S; S.init(XB, wl + WL_CQ, T, DM, DM, DM, G, bx);
            EpiPlain E{QC, DM, part, CQSCALE, 0};
            pg8::gemm_phase<EpiPlain, DenseSched, false, true>(lds, DM, DM, S, E);
        } if (rep_ + 1 < NREP(4)) GRID_BAR(); }
        SEAM(pb + 4);
        for (int rep_ = 0; rep_ < NREP(5); ++rep_) { if (IN(pb + 5) && PEN(5)) {
            for (int u = vcu; u < NB * 4 * 16; u += G) { const int bh = u >> 4, qb = u & 15;
                att::cross_unit(bh >> 2, bh & 3, qb, QC, KVC + (size_t)l * MT * 2048, OC, (char*)lds_raw); }
        } if (rep_ + 1 < NREP(5)) GRID_BAR(); }
        SEAM(pb + 5);
        for (int rep_ = NREP(6) - 1; rep_ >= 0; --rep_) { if (IN(pb + 6) && PEN(6)) {
            DenseSched S; S.init(OC, wl + WL_CO, T, DM, DM, DM, G, bx);
            EpiRes E{xs, rep_ ? (float*)(ws + WS_DUMMY) : xs, rep_ ? (bf16_t*)(ws + WS_DUMMY + 64 * MiB) : XB, rep_ ? (float*)(ws + WS_DUMMY + 96 * MiB) : part};
            pg8::gemm_phase<EpiRes, DenseSched, false, true>(lds, DM, DM, S, E);
        } if (rep_) GRID_BAR(); }
        SEAM(pb + 6);
        if (IN(pb + 7) && PEN(7)) {
            OPQ_LANE();
            const float* We = args.in[I_WRE] + (size_t)l * DM * NE;
            for (int i = tid; i < DM * 8; i += 512) { const int k = i >> 3, c = i & 7; *(LAS f32x4*)(lds + k * 128 + ((c ^ ((k >> 1) & 7)) << 4)) = *(const f32x4*)(We + k * 32 + c * 4); }
            float gf[16]; f32x4 wg[16];
#pragma unroll
            for (int j = 0; j < 16; ++j) { gf[j] = args.in[I_NFFN][l * DM + j * 64 + lane]; wg[j] = *(const f32x4*)(args.in[I_WRG] + (size_t)l * DM * 4 + (j * 64 + lane) * 4); }
            __syncthreads();
            for (int rep_ = NREP(7) - 1; rep_ >= 0; --rep_) {
                int* dmy = (int*)(ws + WS_DUMMY + 97 * MiB);
                for (int t = gw; t < T; t += NGW) route_token(t, xs, part, gf, wg, (const LAS char*)lds, rep_ ? ecnt + 4 * 32 * 64 : ecnt, rep_ ? dmy : elist, rep_ ? dmy + 32 * T : tok_e, rep_ ? dmy + 34 * T : tok_pos, rep_ ? (float*)(dmy + 36 * T) : tok_w, lane);
                if (rep_) GRID_BAR(); }
            __syncthreads();
        }
        SEAM(pb + 7);
        if (IN(pb + 8) || IN(pb + 9) || IN(pb + 10)) {
            OPQ_LANE();
            if (tid < 32) cntL[tid] = (int)__hip_atomic_load(ecnt + tid * 64, __ATOMIC_RELAXED, __HIP_MEMORY_SCOPE_AGENT);
            __syncthreads();
            if (tid == 0) { int a = 0;
#pragma unroll 1
                for (int e = 0; e < 32; ++e) { bst[e] = a; const int nb = (cntL[e] + 255) >> 8;
#pragma unroll 1
                    for (int q = 0; q < nb; ++q) bexp[a + q] = e;
                    a += nb; }
                bst[32] = a; }
            __syncthreads();
        }
        for (int rep_ = 0; rep_ < NREP(8); ++rep_) { if (IN(pb + 8) && PEN(8)) {
            MoeSched S{bst, cntL, bexp, (const char*)XB, (const char*)(wl + WL_GU), elist, (size_t)1536 * DM * 2, (size_t)256 * DM * 2, 6, G, vcu, true};
            EpiGU E{part, ACT};
            pg8::gemm_phase<EpiGU, MoeSched, true, true>(lds, DM, DM, S, E);
        } if (rep_ + 1 < NREP(8)) GRID_BAR(); }
        SEAM(pb + 8);
        for (int rep_ = 0; rep_ < NREP(9); ++rep_) { if (IN(pb + 9) && PEN(9)) {
            MoeSched S{bst, cntL, bexp, (const char*)ACT, (const char*)(wl + WL_DN), elist, (size_t)DM * DE * 2, (size_t)256 * DE * 2, 4, G, vcu, false};
            EpiPlain E{Yb, DM, nullptr, 1.0f, 0};
            pg8::gemm_phase<EpiPlain, MoeSched, false, true>(lds, DE, DE, S, E);
        } if (rep_ + 1 < NREP(9)) GRID_BAR(); }
        SEAM(pb + 9);
        if (IN(pb + 10) && PEN(10)) {
            OPQ_LANE();
            for (int rep_ = NREP(10) - 1; rep_ >= 0; --rep_) {
                for (int t = gw; t < T; t += NGW) combine_row(t, bst, tok_e, tok_pos, tok_w, Yb, xs, rep_ ? (float*)(ws + WS_DUMMY) : xs, rep_ ? (bf16_t*)(ws + WS_DUMMY + 64 * MiB) : XB, rep_ ? (float*)(ws + WS_DUMMY + 96 * MiB) : part, args.in[I_NFIN], l == NL - 1, lane);
                if (rep_) GRID_BAR(); }
        }
        SEAM(pb + 10);
    }
#undef IN
#undef SEAM
#undef GRID_BAR
}

extern "C" void kernel_launch(void* const* d_in, const int* in_sizes, int n_in, void* d_out, int out_size, void* d_ws, size_t ws_size, hipStream_t stream) {
    static int grid = 0;
    if (grid == 0) {
        if (n_in != 24 || in_sizes[0] != T * DM || out_size != T * DM || ws_size < WS_END) {
            fprintf(stderr, "kernel_launch: shape mismatch: n_in %d in0 %d out %d ws %zu (need >= %zu); nothing launched\n", n_in, n_in > 0 ? in_sizes[0] : -1, out_size, ws_size, (size_t)WS_END); grid = -1; return; }
        int dev = 0, cus = 0, per_cu = 0;
        if (hipGetDevice(&dev) != hipSuccess || hipDeviceGetAttribute(&cus, hipDeviceAttributeMultiprocessorCount, dev) != hipSuccess) { fprintf(stderr, "kernel_launch: device query failed\n"); grid = -1; return; }
        if (hipFuncSetAttribute((const void*)fwd, hipFuncAttributeMaxDynamicSharedMemorySize, LDS_BYTES) != hipSuccess) { fprintf(stderr, "kernel_launch: hipFuncSetAttribute failed\n"); grid = -1; return; }
        if (hipOccupancyMaxActiveBlocksPerMultiprocessor(&per_cu, (const void*)fwd, 512, LDS_BYTES) != hipSuccess || per_cu < 1)
            fprintf(stderr, "kernel_launch: note: occupancy query reports %d workgroups per CU\n", per_cu);
        (void)hipGetLastError();
        grid = cus;
    }
    if (grid < 0) return;
    if (hipMemsetAsync((char*)d_ws + WS_CTL, 0, CTL_ZERO_BYTES, stream) != hipSuccess) { fprintf(stderr, "kernel_launch: memset failed\n"); return; }
    Args a{};
    for (int i = 0; i < 24; ++i) a.in[i] = (const float*)d_in[i];
    a.out = (float*)d_out; a.ws = (unsigned char*)d_ws;
#if MK_SPLIT
    for (int ph = 0; ph < NPHASE; ++ph) { a.ph_lo = ph; a.ph_hi = ph + 1; hipLaunchKernelGGL(fwd, dim3(grid), dim3(512), LDS_BYTES, stream, a); }
#else
    a.ph_lo = 0; a.ph_hi = NPHASE; hipLaunchKernelGGL(fwd, dim3(grid), dim3(512), LDS_BYTES, stream, a);
#endif
    const hipError_t le = hipPeekAtLastError();
    if (le != hipSuccess) fprintf(stderr, "kernel_launch: launch failed: %s\n", hipGetErrorName(le));
}
```
